# Optimizing an MI355X kernel written in HIP

```python
import jax
import jax.numpy as jnp
from jax import lax
import numpy as np

D_MODEL = 2048
BATCH = 4
SEQ = 4096
DEPTH = 2

CHUNK = 64
N_MEM = 256
N_BRANCH = 4
BRANCH_WIDTH = D_MODEL // 4
HEAD_DIM = 128
N_HEADS = BRANCH_WIDTH // HEAD_DIM
IDX_HEADS = 8
IDX_DIM = 64
TOPK_MAX = 256
Q_BLOCK = 128
ROPE_BASE = 10000.0
EPS = 1e-6
W = BRANCH_WIDTH
SPLIT_SIZES = (W, W, W, W, IDX_HEADS * IDX_DIM, IDX_DIM, IDX_HEADS,
               W, W, W, W,
               W, W, W, W,
               W, W,
               N_BRANCH * D_MODEL)
IN_WIDTH = sum(SPLIT_SIZES)

kernel_name = 'hybrid_dsa_retnet_hgrn2_gated_block'


def rms_norm(x, g):
    xf = x.astype(jnp.float32)
    y = xf * lax.rsqrt(jnp.mean(xf * xf, axis=-1, keepdims=True) + EPS)
    return (y * g.astype(jnp.float32)).astype(x.dtype)


def head_rms_norm(t, g):
    tf = t.astype(jnp.float32)
    y = tf * lax.rsqrt(jnp.mean(tf * tf, axis=-1, keepdims=True) + EPS)
    return (y * g.astype(jnp.float32)).astype(t.dtype)


def split_cols(u):
    parts = []
    off = 0
    for n in SPLIT_SIZES:
        parts.append(u[..., off:off + n])
        off += n
    return parts


def rope_tables(seq):
    inv = ROPE_BASE ** (-jnp.arange(0, HEAD_DIM, 2, dtype=jnp.float32) / HEAD_DIM)
    ang = jnp.arange(seq, dtype=jnp.float32)[:, None] * inv[None, :]
    return jnp.cos(ang), jnp.sin(ang)


def rope(t, cos, sin):
    half = HEAD_DIM // 2
    t1 = t[..., :half].astype(jnp.float32)
    t2 = t[..., half:].astype(jnp.float32)
    c, s = cos[:, None, :], sin[:, None, :]
    return jnp.concatenate([t1 * c - t2 * s, t1 * s + t2 * c], axis=-1).astype(t.dtype)


def sparse_index_attention(q, k, v, qi, ki, wi):
    B, S, H, Dh = q.shape
    n_sel = min(TOPK_MAX, S // 4)
    nb = S // Q_BLOCK
    key_chunk = jnp.arange(S) // CHUNK

    def to_blocks(t):
        return jnp.moveaxis(t.reshape(B, nb, Q_BLOCK, *t.shape[2:]), 1, 0)

    def block(args):
        start, qb, qib, wib = args
        q_chunk = (start + jnp.arange(Q_BLOCK)) // CHUNK
        visible = key_chunk[None, :] <= q_chunk[:, None]
        rel = jax.nn.relu(jnp.einsum('bqhd,bsd->bqhs', qib, ki).astype(jnp.float32) * IDX_DIM ** -0.5)
        score = jnp.einsum('bqh,bqhs->bqs', wib.astype(jnp.float32) * IDX_HEADS ** -0.5, rel)
        score = jnp.where(visible[None], score, -jnp.inf)
        _, sel = lax.top_k(score, n_sel)
        sel_ok = key_chunk[sel] <= q_chunk[None, :, None]
        ks = jax.vmap(lambda kk, ii: kk[ii])(k, sel)
        vs = jax.vmap(lambda vv, ii: vv[ii])(v, sel)
        logits = jnp.einsum('bqhd,bqkhd->bhqk', qb, ks).astype(jnp.float32) * HEAD_DIM ** -0.5
        logits = jnp.where(sel_ok[:, None], logits, -jnp.inf)
        p = jax.nn.softmax(logits, axis=-1).astype(vs.dtype)
        return jnp.einsum('bhqk,bqkhd->bqhd', p, vs)

    starts = jnp.arange(nb) * Q_BLOCK
    out = lax.map(block, (starts, to_blocks(q), to_blocks(qi), to_blocks(wi)))
    return jnp.moveaxis(out, 0, 1).reshape(B, S, H, Dh)


def retention(q, k, v):
    B, S, H, d = q.shape
    nc = S // CHUNK
    q = q.astype(jnp.float32).reshape(B, nc, CHUNK, H, d)
    k = k.astype(jnp.float32).reshape(B, nc, CHUNK, H, d)
    v = v.astype(jnp.float32).reshape(B, nc, CHUNK, H, d)
    log_g = jnp.log1p(-jnp.exp2(-5.0 - jnp.arange(H, dtype=jnp.float32)))
    pos = jnp.arange(CHUNK, dtype=jnp.float32)
    intra = jnp.exp(log_g[:, None, None] * jnp.abs(pos[:, None] - pos[None, :]))
    s = jnp.einsum('bnchd,bnehd->bnhce', q, k) * intra
    o_intra = jnp.einsum('bnhce,bnehd->bnchd', s, v)
    k_dec = k * jnp.exp(log_g[None, :] * (CHUNK - 1 - pos)[:, None])[:, :, None]
    kv = jnp.einsum('bnehd,bnehv->nbhdv', k_dec, v)
    chunk_decay = jnp.exp(log_g * CHUNK)[None, :, None, None]

    def step(state, kv_n):
        return chunk_decay * state + kv_n, state

    _, s_prev = lax.scan(step, jnp.zeros_like(kv[0]), kv)
    q_dec = q * jnp.exp(log_g[None, :] * (pos + 1.0)[:, None])[:, :, None]
    o_inter = jnp.einsum('bnchd,nbhdv->bnchv', q_dec, s_prev)
    return (o_intra + o_inter).reshape(B, S, H, d)


def hgrn2(f, i, q):
    B, S, H, d = q.shape
    nc = S // CHUNK
    f = f.astype(jnp.float32).reshape(B, nc, CHUNK, H, d)
    i = i.astype(jnp.float32).reshape(B, nc, CHUNK, H, d)
    q = q.astype(jnp.float32).reshape(B, nc, CHUNK, H, d)
    kin = 1.0 - f

    def tmaj(t):
        return jnp.moveaxis(t, 2, 0)

    def step(state, inp):
        f_t, k_t, i_t, q_t = inp
        state = f_t[..., None] * state + k_t[..., None] * i_t[..., None, :]
        return state, jnp.einsum('bnhd,bnhdv->bnhv', q_t, state)

    s0 = jnp.zeros((B, nc, H, d, d), jnp.float32)
    s_local, o_intra = lax.scan(step, s0, (tmaj(f), tmaj(kin), tmaj(i), tmaj(q)))
    o_intra = jnp.moveaxis(o_intra, 0, 2)
    cum = jnp.cumsum(jnp.log(f), axis=2)
    chunk_decay = jnp.exp(cum[:, :, -1])

    def cstep(state, inp):
        dec, sl = inp
        return dec[..., None] * state + sl, state

    _, s_prev = lax.scan(cstep, jnp.zeros((B, H, d, d), jnp.float32),
                         (jnp.moveaxis(chunk_decay, 1, 0), jnp.moveaxis(s_local, 1, 0)))
    o_inter = jnp.einsum('bnchd,nbhdv->bnchv', q * jnp.exp(cum), s_prev)
    return (o_intra + o_inter).reshape(B, S, H, d)


def memory_attention(q, mk, mv):
    logits = jnp.einsum('bshd,bmhd->bhsm', q, mk).astype(jnp.float32) * HEAD_DIM ** -0.5
    p = jax.nn.softmax(logits, axis=-1).astype(mv.dtype)
    return jnp.einsum('bhsm,bmhd->bshd', p, mv)


def hybrid_layer(x, mem, norm_g, w_in, qk_g, ret_g, hgrn_g, lb, w_mem_kv, w_branch, w_out, cos, sin):
    B, S, _ = x.shape
    dt = x.dtype
    h = rms_norm(x, norm_g)
    u = h @ w_in
    (a_q, a_k, a_v, a_z, a_qi, a_ki, a_wi,
     b_q, b_k, b_v, b_z,
     c_f, c_i, c_q, c_z,
     m_q, m_z, gates) = split_cols(u)

    def heads(t):
        return t.reshape(t.shape[0], t.shape[1], N_HEADS, HEAD_DIM)

    y_a = sparse_index_attention(head_rms_norm(heads(a_q), qk_g[0]), head_rms_norm(heads(a_k), qk_g[1]),
                                 heads(a_v), a_qi.reshape(B, S, IDX_HEADS, IDX_DIM), a_ki, a_wi)
    y_b = retention(rope(heads(b_q), cos, sin), rope(heads(b_k), cos, sin) * HEAD_DIM ** -0.5, heads(b_v))
    y_b = head_rms_norm(y_b, ret_g)
    f = lb + (1.0 - lb) * jax.nn.sigmoid(heads(c_f).astype(jnp.float32))
    y_c = head_rms_norm(hgrn2(f, heads(c_i), heads(c_q)), hgrn_g)
    mkv = mem @ w_mem_kv
    m_k, m_v = mkv[..., :W], mkv[..., W:]
    y_m = memory_attention(head_rms_norm(heads(m_q), qk_g[2]), head_rms_norm(heads(m_k), qk_g[3]), heads(m_v))

    gate_all = gates.reshape(B, S, N_BRANCH, D_MODEL)
    merged = jnp.zeros_like(x)
    for n, (y, z) in enumerate(((y_a, a_z), (y_b, b_z), (y_c, c_z), (y_m, m_z))):
        branch = y.reshape(B, S, W).astype(dt) * jax.nn.silu(z)
        merged = merged + jax.nn.sigmoid(gate_all[:, :, n]) * (branch @ w_branch[n])
    return x + merged @ w_out


def setup_inputs(seed: int = 0) -> dict:
    key = jax.random.key(seed)
    ks = jax.random.split(key, 12)
    x = jax.random.normal(ks[0], (BATCH, SEQ, D_MODEL), jnp.float32)
    mem = jax.random.normal(ks[1], (BATCH, N_MEM, D_MODEL), jnp.float32)
    norm_g = 1.0 + 0.02 * jax.random.normal(ks[2], (DEPTH, D_MODEL), jnp.float32)
    w_in = jax.random.normal(ks[3], (DEPTH, D_MODEL, IN_WIDTH), jnp.float32) * D_MODEL ** -0.5
    qk_norm_g = 1.0 + 0.02 * jax.random.normal(ks[4], (DEPTH, 4, HEAD_DIM), jnp.float32)
    ret_norm_g = 1.0 + 0.02 * jax.random.normal(ks[5], (DEPTH, N_HEADS, HEAD_DIM), jnp.float32)
    hgrn_norm_g = 1.0 + 0.02 * jax.random.normal(ks[6], (DEPTH, N_HEADS, HEAD_DIM), jnp.float32)
    lb_logits = 0.5 * jax.random.normal(ks[7], (DEPTH, N_HEADS, HEAD_DIM), jnp.float32)
    w_mem_kv = jax.random.normal(ks[8], (DEPTH, D_MODEL, 2 * W), jnp.float32) * D_MODEL ** -0.5
    w_branch = jax.random.normal(ks[9], (DEPTH, N_BRANCH, W, D_MODEL), jnp.float32) * W ** -0.5
    w_out = jax.random.normal(ks[10], (DEPTH, D_MODEL, D_MODEL), jnp.float32) * D_MODEL ** -0.5
    return {'x': x, 'mem': mem, 'norm_g': norm_g, 'w_in': w_in, 'qk_norm_g': qk_norm_g,
            'ret_norm_g': ret_norm_g, 'hgrn_norm_g': hgrn_norm_g, 'lb_logits': lb_logits,
            'w_mem_kv': w_mem_kv, 'w_branch': w_branch, 'w_out': w_out}


def reference(x, mem, norm_g, w_in, qk_norm_g, ret_norm_g, hgrn_norm_g, lb_logits, w_mem_kv, w_branch, w_out):
    seq = x.shape[1]
    p = jax.nn.softmax(lb_logits.astype(jnp.float32), axis=0)
    lower_bounds = jnp.cumsum(p, axis=0) - p[0:1]
    cos, sin = rope_tables(seq)
    for l in range(DEPTH):
        x = hybrid_layer(x, mem, norm_g[l], w_in[l], qk_norm_g[l], ret_norm_g[l], hgrn_norm_g[l],
                         lower_bounds[l], w_mem_kv[l], w_branch[l], w_out[l], cos, sin)
    return x
```

```cpp
#include <hip/hip_runtime.h>
#include <hip/hip_cooperative_groups.h>
#include <cstdio>
namespace cg = cooperative_groups;

#ifndef PHMASK
#define PHMASK 127
#endif
#ifndef P2SEL
#define P2SEL 7
#endif
#ifndef MULTI_LAUNCH
#define MULTI_LAUNCH 0
#endif

#define DI __device__ __forceinline__
#define LAS __attribute__((address_space(3)))
typedef unsigned short bf16_t;
typedef short bf16x8 __attribute__((ext_vector_type(8)));
typedef short s16x4 __attribute__((ext_vector_type(4)));
typedef float f32x4 __attribute__((ext_vector_type(4)));
typedef float f32x16 __attribute__((ext_vector_type(16)));
typedef unsigned u32x4 __attribute__((ext_vector_type(4)));
typedef unsigned u32x2 __attribute__((ext_vector_type(2)));
typedef unsigned long long u64;

constexpr int T_ = 16384, S_ = 4096, LDU = 16128;
constexpr int A_Q = 0, A_K = 512, A_V = 1024, A_Z = 1536, A_QI = 2048, A_KI = 2560, A_WI = 2624;
constexpr int B_Q = 2816, B_K = 3328, B_V = 3840, B_Z = 4352, C_F = 4864, C_I = 5376, C_Q = 5888, C_Z = 6400, M_Q = 6912, M_Z = 7424, G_OFF = 7936;
constexpr int IN_W = 15944;
constexpr int NPH = 14;

constexpr size_t OFF_WINT = 0;
constexpr size_t OFF_WBRT = OFF_WINT + (size_t)LDU * 2048 * 2;
constexpr size_t OFF_WOUT = OFF_WBRT + (size_t)2048 * 2048 * 2;
constexpr size_t OFF_WMKV = OFF_WOUT + (size_t)2048 * 2048 * 2;
constexpr size_t OFF_MEMB = OFF_WMKV + (size_t)1024 * 2048 * 2;
constexpr size_t OFF_MKV = OFF_MEMB + (size_t)1024 * 2048 * 2;
constexpr size_t OFF_H = OFF_MKV + (size_t)1024 * 1024 * 2;
constexpr size_t OFF_U = OFF_H + (size_t)T_ * 2048 * 2;
constexpr size_t OFF_Y = OFF_U + (size_t)T_ * LDU * 2;
constexpr size_t OFF_R1 = OFF_Y + (size_t)T_ * 2048 * 2;
constexpr size_t OFF_STB = OFF_R1 + (size_t)T_ * 2048 * 4;
constexpr size_t OFF_STC = OFF_STB + (size_t)1024 * 16384 * 4;
constexpr size_t OFF_DEC = OFF_STC + (size_t)1024 * 16384 * 4;
constexpr size_t OFF_MASK = OFF_DEC + (size_t)1024 * 128 * 4;
constexpr size_t OFF_ROPE = OFF_MASK + (size_t)T_ * 64 * 8;
constexpr size_t WS_END = OFF_ROPE + (size_t)2 * 4096 * 64 * 4;
constexpr size_t OFF_BAR = WS_END;
constexpr size_t BAR_BYTES = 3456 * 4;
constexpr size_t WS_NEED = OFF_BAR + BAR_BYTES;
constexpr int LDS_BYTES = 131072 + 16;

struct Params {
    const float *x, *mem, *norm_g, *w_in, *qk_g, *ret_g, *hgrn_g, *lb_logits, *w_mem_kv, *w_branch, *w_out;
    float* out;
    unsigned char* ws;
    int ph_lo, ph_hi, coop, pad;
};

DI float bf2f(bf16_t b) { return __uint_as_float(((unsigned)b) << 16); }
typedef __bf16 hbf16x2 __attribute__((ext_vector_type(2)));
typedef float f32x2 __attribute__((ext_vector_type(2)));
DI unsigned pk2(float lo, float hi) { const f32x2 v = {lo, hi}; return __builtin_bit_cast(unsigned, __builtin_convertvector(v, hbf16x2)); }
DI bf16_t f2bf(float x) { return (bf16_t)(pk2(x, 0.f) & 0xffffu); }
DI float lo16(unsigned w) { return __uint_as_float(w << 16); }
DI float hi16(unsigned w) { return __uint_as_float(w & 0xffff0000u); }
DI float sigmoidf_(float x) { return 1.0f / (1.0f + __expf(-x)); }
DI float siluf_(float x) { return x / (1.0f + __expf(-x)); }
DI f32x16 zero16() { f32x16 z; for (int i = 0; i < 16; ++i) z[i] = 0.f; return z; }
#define MFMA32(a, b, c) __builtin_amdgcn_mfma_f32_32x32x16_bf16((a), (b), (c), 0, 0, 0)
DI bf16x8 pack8(float a0, float a1, float a2, float a3, float a4, float a5, float a6, float a7) {
    u32x4 w; w.x = pk2(a0, a1); w.y = pk2(a2, a3); w.z = pk2(a4, a5); w.w = pk2(a6, a7);
    return __builtin_bit_cast(bf16x8, w);
}
DI void unpack8(const u32x4 w, float* f) {
    f[0] = lo16(w.x); f[1] = hi16(w.x); f[2] = lo16(w.y); f[3] = hi16(w.y); f[4] = lo16(w.z); f[5] = hi16(w.z); f[6] = lo16(w.w); f[7] = hi16(w.w);
}

namespace pg8 {
constexpr int BM = 256, BK = 64, HALF = 128, HTB = HALF * BK * 2, NXCD = 8, WGM = 8;
DI int lds_byte(int r, int c) { const int st = (r >> 4) * 2 + (c >> 5), rr = r & 15, cc = c & 31, ob = rr * 64 + cc * 2; return st * 1024 + (ob ^ (((ob >> 9) & 1) << 5)); }
DI void stage_rc(int b, int& R, int& C) { const int st = b / 1024, sb = b % 1024, swz = sb ^ (((sb >> 9) & 1) << 5); R = (st >> 1) * 16 + swz / 64; C = (st & 1) * 32 + (swz % 64) / 2; }
DI int perm32(int rho) { const int n = rho >> 4, i = rho & 15; return 8 * (i >> 2) + 4 * n + (i & 3); }
struct Unit { int pm, pn; };
struct Gemm { const bf16_t* A; const bf16_t* Bt; int lda, ldb, M, N, K; };
struct StaticOrder {
    int nM, nN, nwg, G, c;
    DI void init(int M, int N, int G_, int c_) { nM = M / BM; nN = N / BM; nwg = nM * nN; G = G_; c = c_; }
    DI bool next(int i, Unit& u) const {
        const long L = (long)i * G + c; if (L >= nwg) return false;
        int wgid = (int)L; { const int q = nwg / NXCD, r = nwg % NXCD, xcd = wgid % NXCD, off = wgid / NXCD; wgid = (xcd < r ? xcd * (q + 1) : r * (q + 1) + (xcd - r) * q) + off; }
        const int nig = WGM * nN, gid = wgid / nig, fm = gid * WGM, gsz = (nM - fm) < WGM ? (nM - fm) : WGM;
        u.pm = fm + ((wgid % nig) % gsz); u.pn = (wgid % nig) / gsz; return true;
    }
};

struct NoHook { static constexpr bool ON = false; DI void operator()(f32x4 (&)[2][2][4][2], const Unit&, int, int, int, int, int) const {} };
template <class Epi, class Hook = NoHook>
DI void gemm_phase(const int tid, LAS unsigned char* lds, const Gemm g, const StaticOrder& S, const Epi& E, const Hook& HK = Hook()) {
    const int wid = __builtin_amdgcn_readfirstlane(tid >> 6), lane = tid & 63, wr = wid >> 2, wc = wid & 3, fr = lane & 15, fq = lane >> 4;
    const int K = g.K, nt = K / BK;
    unsigned voffA[2], voffB[2];
#pragma unroll
    for (int i = 0; i < 2; ++i) { int R, C; stage_rc(tid * 16 + i * 8192, R, C); const int Rb = Epi::PERM ? ((R & ~31) + perm32(R & 31)) : R;
        voffA[i] = (unsigned)(R * g.lda + C) * 2u; voffB[i] = (unsigned)(Rb * g.ldb + C) * 2u; }
    const size_t kstep = (size_t)(BK * 2);
    const size_t hstepA = (size_t)HALF * g.lda * 2, hstepB = (size_t)HALF * g.ldb * 2;
    const size_t tstepA = 2 * hstepA, tstepB = 2 * hstepB;
    const unsigned ldsw = (unsigned)wid * 1024u;
    const int aoff = lds_byte(wr * 64 + fr, fq * 8), boff = lds_byte(wc * 32 + fr, fq * 8);
#define PG8_SA(b, h) (((b) * 2 + (h)) * HTB)
#define PG8_SB(b, h) ((4 + (b) * 2 + (h)) * HTB)
#define PG8_STAGE(bufoff, gbase, voff) do { _Pragma("unroll") for (int _i = 0; _i < 2; ++_i) \
        __builtin_amdgcn_global_load_lds((const unsigned*)((const char*)(gbase) + (voff)[_i]), (LAS unsigned*)(lds + (bufoff) + ldsw + _i * 8192), 16, 0, 0); } while (0)
#define PG8_LDA(dst, b, h) do { _Pragma("unroll") for (int m = 0; m < 4; ++m) _Pragma("unroll") for (int k = 0; k < 2; ++k) dst[m][k] = *(const LAS bf16x8*)(lds + PG8_SA(b, h) + aoff + m * 2048 + k * 1024); } while (0)
#define PG8_LDB(dst, b, h) do { _Pragma("unroll") for (int n = 0; n < 2; ++n) _Pragma("unroll") for (int k = 0; k < 2; ++k) dst[n][k] = *(const LAS bf16x8*)(lds + PG8_SB(b, h) + boff + n * 2048 + k * 1024); } while (0)
#define PG8_MMA(ai, bj, At, Bt) do { __builtin_amdgcn_s_setprio(1); _Pragma("unroll") for (int m = 0; m < 4; ++m) _Pragma("unroll") for (int n = 0; n < 2; ++n) _Pragma("unroll") for (int k = 0; k < 2; ++k) \
        acc[ai][bj][m][n] = __builtin_amdgcn_mfma_f32_16x16x32_bf16(Bt[n][k], At[m][k], acc[ai][bj][m][n], 0, 0, 0); __builtin_amdgcn_s_setprio(0); } while (0)
#define PG8_WAIT_V(n) asm volatile("s_waitcnt vmcnt(" #n ")" ::: "memory")
#define PG8_WAIT_L(n) asm volatile("s_waitcnt lgkmcnt(" #n ")" ::: "memory")
#define PG8_BAR __builtin_amdgcn_s_barrier()
#define PG8_SCHED __builtin_amdgcn_sched_barrier(0)
    Unit cur, nxt; int ui = 0;
    if (!S.next(0, cur)) return;
    f32x4 acc[2][2][4][2];
#pragma unroll
    for (int a = 0; a < 2; ++a)
#pragma unroll
        for (int b = 0; b < 2; ++b)
#pragma unroll
            for (int m = 0; m < 4; ++m)
#pragma unroll
                for (int n = 0; n < 2; ++n) acc[a][b][m][n] = (f32x4){0.f, 0.f, 0.f, 0.f};
    bf16x8 At[4][2], B0[2][2], B1[2][2];
    const char* cA = (const char*)g.A + (size_t)cur.pm * tstepA; const char* cB = (const char*)g.Bt + (size_t)cur.pn * tstepB;
    PG8_STAGE(PG8_SB(0, 0), cB, voffB); PG8_STAGE(PG8_SA(0, 0), cA, voffA); PG8_STAGE(PG8_SB(0, 1), cB + hstepB, voffB); PG8_STAGE(PG8_SA(0, 1), cA + hstepA, voffA);
    if (wr == 1) PG8_BAR;
    PG8_WAIT_V(4); PG8_BAR;
    PG8_STAGE(PG8_SB(1, 0), cB + kstep, voffB); PG8_STAGE(PG8_SA(1, 0), cA + kstep, voffA); PG8_STAGE(PG8_SB(1, 1), cB + hstepB + kstep, voffB);
    PG8_WAIT_V(6); PG8_BAR;
    for (;;) {
        const bool has_next = S.next(ui + 1, nxt);
        const char* nA = has_next ? (const char*)g.A + (size_t)nxt.pm * tstepA : cA; const char* nB = has_next ? (const char*)g.Bt + (size_t)nxt.pn * tstepB : cB;
        for (int t = 0; t < nt; t += 2) {
            const bool last = (t == nt - 2);
            const char* a1 = cA + (size_t)(t + 1) * kstep;
            const char* a2 = last ? nA : cA + (size_t)(t + 2) * kstep; const char* b2 = last ? nB : cB + (size_t)(t + 2) * kstep;
            const char* a3 = a2 + kstep; const char* b3 = b2 + kstep;
            PG8_LDB(B0, 0, 0); PG8_SCHED; PG8_LDA(At, 0, 0); PG8_STAGE(PG8_SA(1, 1), a1 + hstepA, voffA);
            PG8_WAIT_L(8); PG8_BAR; PG8_WAIT_L(0); PG8_MMA(0, 0, At, B0); PG8_BAR; PG8_SCHED;
            PG8_LDB(B1, 0, 1); PG8_STAGE(PG8_SB(0, 0), b2, voffB);
            PG8_BAR; PG8_WAIT_L(0); PG8_MMA(0, 1, At, B1); PG8_BAR;
            PG8_LDA(At, 0, 1); PG8_STAGE(PG8_SA(0, 0), a2, voffA);
            PG8_BAR; PG8_WAIT_L(0); PG8_MMA(1, 0, At, B0); PG8_BAR; PG8_SCHED;
            PG8_STAGE(PG8_SB(0, 1), b2 + hstepB, voffB);
            PG8_WAIT_V(6); PG8_BAR; PG8_MMA(1, 1, At, B1); PG8_BAR;
            PG8_LDB(B0, 1, 0); PG8_SCHED; PG8_LDA(At, 1, 0); PG8_STAGE(PG8_SA(0, 1), a2 + hstepA, voffA);
            PG8_WAIT_L(8); PG8_BAR; PG8_WAIT_L(0); PG8_MMA(0, 0, At, B0); PG8_BAR; PG8_SCHED;
            PG8_LDB(B1, 1, 1); PG8_STAGE(PG8_SB(1, 0), b3, voffB);
            PG8_BAR; PG8_WAIT_L(0); PG8_MMA(0, 1, At, B1); PG8_BAR;
            PG8_LDA(At, 1, 1); PG8_STAGE(PG8_SA(1, 0), a3, voffA);
            PG8_BAR; PG8_WAIT_L(0); PG8_MMA(1, 0, At, B0); PG8_BAR; PG8_SCHED;
            PG8_STAGE(PG8_SB(1, 1), b3 + hstepB, voffB);
            PG8_WAIT_V(6); PG8_BAR; PG8_MMA(1, 1, At, B1); PG8_BAR;
            if (Hook::ON) { PG8_SCHED; HK(acc, cur, t, wr, wc, fr, fq); PG8_SCHED; }
        }
        E(acc, cur, wr, wc, fr, fq);
        if (!has_next) break;
#pragma unroll
        for (int a = 0; a < 2; ++a)
#pragma unroll
            for (int b = 0; b < 2; ++b)
#pragma unroll
                for (int m = 0; m < 4; ++m)
#pragma unroll
                    for (int n = 0; n < 2; ++n) acc[a][b][m][n] = (f32x4){0.f, 0.f, 0.f, 0.f};
        cur = nxt; cA = nA; cB = nB; ++ui;
    }
    PG8_WAIT_V(0);
    if (wr == 0) PG8_BAR;
    PG8_BAR;
#undef PG8_SA
#undef PG8_SB
#undef PG8_STAGE
#undef PG8_LDA
#undef PG8_LDB
#undef PG8_MMA
#undef PG8_WAIT_V
#undef PG8_WAIT_L
#undef PG8_BAR
#undef PG8_SCHED
}

struct EpiBf16 {
    static constexpr bool PERM = true;
    bf16_t* O; int ldc; int sig_pn;
    DI void operator()(const f32x4 (&acc)[2][2][4][2], const Unit& u, int wr, int wc, int fr, int fq) const {
        const int row0 = u.pm * BM + wr * 64 + fr, col0 = u.pn * BM + wc * 32 + 8 * fq;
        const bool sg = u.pn >= sig_pn;
#pragma unroll
        for (int ai = 0; ai < 2; ++ai)
#pragma unroll
            for (int m = 0; m < 4; ++m) { bf16_t* rowp = O + (size_t)(row0 + ai * HALF + m * 16) * ldc + col0;
#pragma unroll
                for (int bj = 0; bj < 2; ++bj) { f32x4 v0 = acc[ai][bj][m][0], v1 = acc[ai][bj][m][1];
                    if (sg) {
#pragma unroll
                        for (int j = 0; j < 4; ++j) { v0[j] = sigmoidf_(v0[j]); v1[j] = sigmoidf_(v1[j]); } }
                    u32x4 w; w.x = pk2(v0[0], v0[1]); w.y = pk2(v0[2], v0[3]); w.z = pk2(v1[0], v1[1]); w.w = pk2(v1[2], v1[3]);
                    *(u32x4*)(rowp + bj * HALF) = w; }
                __builtin_amdgcn_sched_barrier(0); }
    }
};
struct EpiGateRatio {
    static constexpr bool PERM = false;
    bf16_t* U;
    DI void operator()(const f32x4 (&acc)[2][2][4][2], const Unit& u, int wr, int wc, int fr, int fq) const {
        const int row0 = u.pm * BM + wr * 64 + fr, c0 = u.pn * 64 + 16 * wc + 4 * fq;
#pragma unroll
        for (int ai = 0; ai < 2; ++ai)
#pragma unroll
            for (int m = 0; m < 4; ++m) { bf16_t* rowp = U + (size_t)(row0 + ai * HALF + m * 16) * LDU + G_OFF + c0;
                float r0[4], r1[4], r2[4], g3[4];
#pragma unroll
                for (int j = 0; j < 4; ++j) { const float e0 = __expf(-acc[ai][0][m][0][j]), e1 = __expf(-acc[ai][0][m][1][j]), e2 = __expf(-acc[ai][1][m][0][j]), e3 = __expf(-acc[ai][1][m][1][j]);
                    const float i0 = __builtin_amdgcn_rcpf(1.0f + e0), i1 = __builtin_amdgcn_rcpf(1.0f + e1), i2 = __builtin_amdgcn_rcpf(1.0f + e2), i3 = __builtin_amdgcn_rcpf(1.0f + e3);
                    r0[j] = (1.0f + e1) * i0; r1[j] = (1.0f + e2) * i1; r2[j] = (1.0f + e3) * i2; g3[j] = i3; }
                u32x2 w;
                w.x = pk2(r0[0], r0[1]); w.y = pk2(r0[2], r0[3]); *(u32x2*)(rowp) = w;
                w.x = pk2(r1[0], r1[1]); w.y = pk2(r1[2], r1[3]); *(u32x2*)(rowp + 2048) = w;
                w.x = pk2(r2[0], r2[1]); w.y = pk2(r2[2], r2[3]); *(u32x2*)(rowp + 4096) = w;
                w.x = pk2(g3[0], g3[1]); w.y = pk2(g3[2], g3[3]); *(u32x2*)(rowp + 6144) = w;
                __builtin_amdgcn_sched_barrier(0); }
    }
};
struct HookGate {
    static constexpr bool ON = true;
    const bf16_t* U;
    DI void operator()(f32x4 (&acc)[2][2][4][2], const Unit& u, int t, int wr, int wc, int fr, int fq) const {
        if ((t & 7) != 6 || t >= 24) return;
        const int seg = t >> 3;
        int row0 = u.pm * BM + wr * 64 + fr, col0 = u.pn * BM + wc * 32 + 4 * fq;
        asm volatile("" : "+v"(row0), "+v"(col0));
#pragma unroll
        for (int ai = 0; ai < 2; ++ai) {
            u32x2 ga[4][4];
#pragma unroll
            for (int m = 0; m < 4; ++m) { const bf16_t* gp = U + (size_t)(row0 + ai * HALF + m * 16) * LDU + G_OFF + seg * 2048 + col0;
#pragma unroll
                for (int bj = 0; bj < 2; ++bj)
#pragma unroll
                    for (int n = 0; n < 2; ++n) ga[m][bj * 2 + n] = *(const u32x2*)(gp + bj * HALF + n * 16); }
#pragma unroll
            for (int m = 0; m < 4; ++m)
#pragma unroll
                for (int bj = 0; bj < 2; ++bj)
#pragma unroll
                    for (int n = 0; n < 2; ++n) { const u32x2 a = ga[m][bj * 2 + n];
                        f32x4& v = acc[ai][bj][m][n];
                        v[0] *= lo16(a.x); v[1] *= hi16(a.x); v[2] *= lo16(a.y); v[3] *= hi16(a.y); }
            __builtin_amdgcn_sched_barrier(0); }
    }
};
struct EpiMerged {
    static constexpr bool PERM = false;
    bf16_t* Mb; const bf16_t* U;
    DI void operator()(const f32x4 (&acc)[2][2][4][2], const Unit& u, int wr, int wc, int fr, int fq) const {
        const int row0 = u.pm * BM + wr * 64 + fr, col0 = u.pn * BM + wc * 32 + 4 * fq;
#pragma unroll
        for (int ai = 0; ai < 2; ++ai) {
            u32x2 gw[4][4];
#pragma unroll
            for (int m = 0; m < 4; ++m) { const size_t row = (size_t)(row0 + ai * HALF + m * 16);
#pragma unroll
                for (int bj = 0; bj < 2; ++bj)
#pragma unroll
                    for (int n = 0; n < 2; ++n) gw[m][bj * 2 + n] = *(const u32x2*)(U + row * LDU + G_OFF + 3 * 2048 + col0 + bj * HALF + n * 16); }
#pragma unroll
            for (int m = 0; m < 4; ++m) { const size_t row = (size_t)(row0 + ai * HALF + m * 16);
#pragma unroll
                for (int bj = 0; bj < 2; ++bj)
#pragma unroll
                    for (int n = 0; n < 2; ++n) { const int col = col0 + bj * HALF + n * 16; const u32x2 g = gw[m][bj * 2 + n];
                        const f32x4 v = acc[ai][bj][m][n];
                        u32x2 w; w.x = pk2(v[0] * lo16(g.x), v[1] * hi16(g.x)); w.y = pk2(v[2] * lo16(g.y), v[3] * hi16(g.y));
                        *(u32x2*)(Mb + row * 2048 + col) = w; } }
            __builtin_amdgcn_sched_barrier(0); }
    }
};
struct EpiOut {
    static constexpr bool PERM = false;
    const float* xin; float* out;
    DI void operator()(const f32x4 (&acc)[2][2][4][2], const Unit& u, int wr, int wc, int fr, int fq) const {
        const int row0 = u.pm * BM + wr * 64 + fr, col0 = u.pn * BM + wc * 32 + 4 * fq;
#pragma unroll
        for (int ai = 0; ai < 2; ++ai) {
            f32x4 xv[4][4];
#pragma unroll
            for (int m = 0; m < 4; ++m) { const size_t row = (size_t)(row0 + ai * HALF + m * 16);
#pragma unroll
                for (int bj = 0; bj < 2; ++bj)
#pragma unroll
                    for (int n = 0; n < 2; ++n) xv[m][bj * 2 + n] = *(const f32x4*)(xin + row * 2048 + col0 + bj * HALF + n * 16); }
#pragma unroll
            for (int m = 0; m < 4; ++m) { const size_t row = (size_t)(row0 + ai * HALF + m * 16);
#pragma unroll
                for (int bj = 0; bj < 2; ++bj)
#pragma unroll
                    for (int n = 0; n < 2; ++n) *(f32x4*)(out + row * 2048 + col0 + bj * HALF + n * 16) = xv[m][bj * 2 + n] + acc[ai][bj][m][n]; }
            __builtin_amdgcn_sched_barrier(0); }
    }
};
}

DI void tr_tile(const int tid, bf16_t* sT, const float* __restrict__ src, int ld_src, int k0, int n0, bf16_t* __restrict__ dst, int ld_dst, int koff, bool winmap) {
    const int n4 = (tid & 31) * 4, kb = tid >> 5;
    const int n = n0 + n4; int sc = n;
    if (winmap) {
        if (n < G_OFF) sc = (n < 2632) ? n : (n < 2816 ? -1 : n - 184);
        else {
            const int t = n - G_OFF, tc = t & 255, bj = tc >> 7, wc = (tc >> 5) & 3, n1 = (tc >> 4) & 1, fq = (tc >> 2) & 3;
            sc = (G_OFF - 184) + (2 * bj + n1) * 2048 + 64 * (t >> 8) + 16 * wc + 4 * fq; }
    }
    f32x4 v[4];
#pragma unroll
    for (int i = 0; i < 4; ++i) v[i] = (sc >= 0) ? *(const f32x4*)(src + (size_t)(k0 + i * 16 + kb) * ld_src + sc) : (f32x4){0.f, 0.f, 0.f, 0.f};
#pragma unroll
    for (int i = 0; i < 4; ++i)
#pragma unroll
        for (int e = 0; e < 4; ++e) sT[(n4 + e) * 66 + i * 16 + kb] = f2bf(v[i][e]);
    __syncthreads();
#pragma unroll
    for (int h = 0; h < 2; ++h) { const int n2 = (tid >> 3) + h * 64, kc = (tid & 7) * 8; const unsigned* sp = (const unsigned*)(sT + n2 * 66 + kc);
        u32x4 w; w.x = sp[0]; w.y = sp[1]; w.z = sp[2]; w.w = sp[3];
        *(u32x4*)(dst + (size_t)(n0 + n2) * ld_dst + koff + k0 + kc) = w; }
    __syncthreads();
}

DI void phase_prep(const int tid, const int bid, unsigned char* smem, const Params& p, int l) {
    bf16_t* sT = (bf16_t*)smem;
    const int G = gridDim.x, wid = tid >> 6, lane = tid & 63;
    bf16_t* WinT = (bf16_t*)(p.ws + OFF_WINT); bf16_t* WbrT = (bf16_t*)(p.ws + OFF_WBRT); bf16_t* WoutT = (bf16_t*)(p.ws + OFF_WOUT); bf16_t* WmkvT = (bf16_t*)(p.ws + OFF_WMKV);
    for (int t = bid; t < 4032 + 512 + 512 + 256; t += G) {
        if (t < 4032) { const int kt = t & 31, ntl = t >> 5; tr_tile(tid, sT, p.w_in + (size_t)l * 2048 * IN_W, IN_W, kt * 64, ntl * 128, WinT, 2048, 0, true); }
        else if (t < 4544) { const int u = t - 4032, nb = u >> 7, rem = u & 127, kt = rem & 7, ct = rem >> 3;
            tr_tile(tid, sT, p.w_branch + ((size_t)(l * 4 + nb) * 512) * 2048, 2048, kt * 64, ct * 128, WbrT, 2048, nb * 512, false); }
        else if (t < 5056) { const int u = t - 4544, kt = u & 31, ntl = u >> 5; tr_tile(tid, sT, p.w_out + (size_t)l * 2048 * 2048, 2048, kt * 64, ntl * 128, WoutT, 2048, 0, false); }
        else { const int u = t - 5056, kt = u & 31, ntl = u >> 5; tr_tile(tid, sT, p.w_mem_kv + (size_t)l * 2048 * 1024, 1024, kt * 64, ntl * 128, WmkvT, 2048, 0, false); }
    }
    const float* xin = l == 0 ? p.x : p.out; const float* g = p.norm_g + l * 2048; bf16_t* H = (bf16_t*)(p.ws + OFF_H);
    for (int row = bid * 8 + wid; row < T_; row += G * 8) {
        const float* xr = xin + (size_t)row * 2048; f32x4 v[8]; float ss = 0.f;
#pragma unroll
        for (int i = 0; i < 8; ++i) { v[i] = *(const f32x4*)(xr + i * 256 + lane * 4); ss += v[i][0] * v[i][0] + v[i][1] * v[i][1] + v[i][2] * v[i][2] + v[i][3] * v[i][3]; }
#pragma unroll
        for (int m = 32; m >= 1; m >>= 1) ss += __shfl_xor(ss, m);
        const float rs = rsqrtf(ss * (1.f / 2048.f) + 1e-6f);
#pragma unroll
        for (int i = 0; i < 8; ++i) { const f32x4 gg = *(const f32x4*)(g + i * 256 + lane * 4); u32x2 w; w.x = pk2(v[i][0] * rs * gg[0], v[i][1] * rs * gg[1]); w.y = pk2(v[i][2] * rs * gg[2], v[i][3] * rs * gg[3]);
            *(u32x2*)(H + (size_t)row * 2048 + i * 256 + lane * 4) = w; }
    }
    if (l == 0) {
        bf16_t* memb = (bf16_t*)(p.ws + OFF_MEMB);
        for (int i = bid * 512 + tid; i < 1024 * 2048 / 4; i += G * 512) { const f32x4 v = *(const f32x4*)(p.mem + (size_t)i * 4); u32x2 w; w.x = pk2(v[0], v[1]); w.y = pk2(v[2], v[3]); *(u32x2*)(memb + (size_t)i * 4) = w; }
        float* rope = (float*)(p.ws + OFF_ROPE);
        for (int i = bid * 512 + tid; i < 4096 * 64; i += G * 512) { const int pos = i >> 6, fi = i & 63;
            const float inv = __builtin_amdgcn_exp2f(-(float)fi * (13.287712379549449f / 64.f));
            const float ang = (float)pos * inv;
            const double rev = (double)ang * 0.15915494309189535; const float fr = (float)(rev - floor(rev));
            rope[i] = __builtin_amdgcn_cosf(fr); rope[4096 * 64 + i] = __builtin_amdgcn_sinf(fr); }
    }
}

template <int K>
DI u64 select_row(const float* __restrict__ rowp, const int nvalid  , unsigned* sS, const int lane) {
    unsigned key[K];
    const bool act = lane * K < nvalid;
    const float* sp = rowp + (act ? lane : 0) * K;
#pragma unroll
    for (int j4 = 0; j4 < K / 4; ++j4) { const f32x4 v4 = *(const f32x4*)(sp + 4 * j4);
#pragma unroll
        for (int e = 0; e < 4; ++e) { const float v = v4[e] + 0.0f; const unsigned u = __float_as_uint(v); const unsigned k = (u & 0x80000000u) ? ~u : (u | 0x80000000u); key[4 * j4 + e] = act ? k : 0u; } }
#define COUNT_GE(cand_, out_) do { int cs_ = 0, cv_ = 0; \
        _Pragma("unroll") for (int j = 0; j < K; j += 8) { \
            const u64 m0_ = __ballot(key[j] >= (cand_)), m1_ = __ballot(key[j + 1] >= (cand_)), m2_ = __ballot(key[j + 2] >= (cand_)), m3_ = __ballot(key[j + 3] >= (cand_)), m4_ = __ballot(key[j + 4] >= (cand_)), m5_ = __ballot(key[j + 5] >= (cand_)); \
            cv_ += (key[j + 6] >= (cand_)) ? 1 : 0; cv_ += (key[j + 7] >= (cand_)) ? 1 : 0; \
            __builtin_amdgcn_sched_barrier(0); \
            cs_ += __popcll(m0_) + __popcll(m1_) + __popcll(m2_) + __popcll(m3_) + __popcll(m4_) + __popcll(m5_); \
            __builtin_amdgcn_sched_barrier(0); } \
        cv_ += __builtin_amdgcn_update_dpp(0, cv_, 0xB1, 0xf, 0xf, false); cv_ += __builtin_amdgcn_update_dpp(0, cv_, 0x4E, 0xf, 0xf, false); \
        cv_ += __builtin_amdgcn_update_dpp(0, cv_, 0x141, 0xf, 0xf, false); cv_ += __builtin_amdgcn_update_dpp(0, cv_, 0x140, 0xf, 0xf, false); \
        out_ = cs_ + __builtin_amdgcn_readlane(cv_, 0) + __builtin_amdgcn_readlane(cv_, 16) + __builtin_amdgcn_readlane(cv_, 32) + __builtin_amdgcn_readlane(cv_, 48); } while (0)
    unsigned Tk = 0u; int cge = 64 * K, cab = 0;
    for (int bit = 31; bit >= 16; --bit) { const unsigned cand = Tk | (1u << bit); int cnt; COUNT_GE(cand, cnt); if (cnt >= 256) { Tk = cand; cge = cnt; } else cab = cnt; }
    const int nsurv = cge - cab, needb = 256 - cab;
    int tot_ge;
    if (nsurv <= 64) {
        int ns = 0;
#pragma unroll
        for (int j = 0; j < K; ++j) ns += ((key[j] >> 16) == (Tk >> 16)) ? 1 : 0;
        int pre = ns;
#pragma unroll
        for (int m = 1; m < 64; m <<= 1) { const int o = __shfl_up(pre, m); if (lane >= m) pre += o; }
        int pos = pre - ns;
#pragma unroll
        for (int j = 0; j < K; ++j) { const bool is = (key[j] >> 16) == (Tk >> 16); sS[is ? pos : 64 + lane] = key[j]; pos += is ? 1 : 0; }
        const unsigned sk = (lane < nsurv) ? sS[lane] : 0u;
        int cgb = nsurv;
        for (int bit = 15; bit >= 0; --bit) { const unsigned cand = Tk | (1u << bit); const int cnt = __popcll(__ballot(sk >= cand)); if (cnt >= needb) { Tk = cand; cgb = cnt; } }
        tot_ge = cab + cgb;
    } else {
        for (int bit = 15; bit >= 0; --bit) { const unsigned cand = Tk | (1u << bit); int cnt; COUNT_GE(cand, cnt); if (cnt >= 256) { Tk = cand; cge = cnt; } }
        tot_ge = cge;
    }
#undef COUNT_GE
    u64 bits = 0ull;
    if (tot_ge == 256) {
        unsigned lo = 0u, hi = 0u;
#pragma unroll
        for (int j = 0; j < 32; ++j) { lo |= (key[j] >= Tk) ? (1u << j) : 0u; if (K == 64) hi |= (key[(K == 64 ? 32 : 0) + j] >= Tk) ? (1u << j) : 0u; }
        bits = (u64)lo | ((u64)hi << 32);
    } else {
        int tg = 0, ceq = 0;
#pragma unroll
        for (int j = 0; j < K; ++j) { tg += __popcll(__ballot(key[j] > Tk)); ceq += (key[j] == Tk) ? 1 : 0; if ((j & 3) == 3) __builtin_amdgcn_sched_barrier(0); }
        const int need = 256 - tg;
#pragma unroll
        for (int j = 0; j < K; ++j) asm volatile("" : "+v"(key[j]));
        int pre = ceq;
#pragma unroll
        for (int m = 1; m < 64; m <<= 1) { const int o = __shfl_up(pre, m); if (lane >= m) pre += o; }
        int run = pre - ceq;
#pragma unroll
        for (int j = 0; j < K; ++j) { const bool eq = key[j] == Tk; const bool sel = (key[j] > Tk) || (eq && run < need); run += eq ? 1 : 0; bits |= sel ? (1ull << j) : 0ull; if ((j & 3) == 3) __builtin_amdgcn_sched_barrier(0); }
    }
    return bits;
}

DI void index_item(const int tid, const int bid, unsigned char* smem, const Params& p, int b, int c, int qhalf) {
    bf16_t* sQi = (bf16_t*)smem;
    const bf16_t* U = (const bf16_t*)(p.ws + OFF_U);
    float* scr = (float*)(p.ws + OFF_R1) + (size_t)bid * (32 * 4096);
    u64* mask = (u64*)(p.ws + OFF_MASK);
    const int wid = tid >> 6, lane = tid & 63, l31 = lane & 31, hh = lane >> 5;
    const int ntile = c + 1, q0 = c * 64 + qhalf * 32; const size_t rowb = (size_t)b * S_;
    __syncthreads();
#pragma unroll
    for (int i = 0; i < 4; ++i) { const int ch = tid + i * 512, r = ch >> 6, cc = (ch & 63) * 8;
        *(u32x4*)(sQi + r * 520 + cc) = *(const u32x4*)(U + (rowb + q0 + r) * LDU + A_QI + cc); }
    float* sW = (float*)(smem + 33280);
    if (tid < 256) { const int r = tid >> 3, hd = tid & 7; sW[tid] = bf2f(U[(rowb + q0 + r) * LDU + A_WI + hd]) * (0.125f * 0.35355339059327373f); }
    __syncthreads();
    bf16x8 kfn[2][4];
    if (wid < ntile) {
#pragma unroll
        for (int mt = 0; mt < 2; ++mt)
#pragma unroll
            for (int s = 0; s < 4; ++s) kfn[mt][s] = *(const bf16x8*)(U + (rowb + wid * 64 + 32 * mt + l31) * LDU + A_KI + 16 * s + 8 * hh);
    }
    for (int kt = wid; kt < ntile; kt += 8) {
        bf16x8 kf[2][4];
#pragma unroll
        for (int mt = 0; mt < 2; ++mt)
#pragma unroll
            for (int s = 0; s < 4; ++s) kf[mt][s] = kfn[mt][s];
        if (kt + 8 < ntile) {
#pragma unroll
            for (int mt = 0; mt < 2; ++mt)
#pragma unroll
                for (int s = 0; s < 4; ++s) kfn[mt][s] = *(const bf16x8*)(U + (rowb + (kt + 8) * 64 + 32 * mt + l31) * LDU + A_KI + 16 * s + 8 * hh);
        }
        f32x16 sc[2]; sc[0] = zero16(); sc[1] = zero16();
#pragma unroll 1
        for (int hd = 0; hd < 8; ++hd) {
            bf16x8 qv[4];
#pragma unroll
            for (int s = 0; s < 4; ++s) qv[s] = *(const bf16x8*)(sQi + l31 * 520 + hd * 64 + 16 * s + 8 * hh);
            const float wv = sW[l31 * 8 + hd];
#pragma unroll
            for (int mt = 0; mt < 2; ++mt) { f32x16 rel = zero16();
#pragma unroll
                for (int s = 0; s < 4; ++s) rel = MFMA32(kf[mt][s], qv[s], rel);
#pragma unroll
                for (int r = 0; r < 16; ++r) sc[mt][r] += fmaxf(rel[r], 0.f) * wv; }
        }
#pragma unroll
        for (int mt = 0; mt < 2; ++mt)
#pragma unroll
            for (int rg = 0; rg < 4; ++rg) { f32x4 v; v[0] = sc[mt][4 * rg]; v[1] = sc[mt][4 * rg + 1]; v[2] = sc[mt][4 * rg + 2]; v[3] = sc[mt][4 * rg + 3];
                *(f32x4*)(scr + (size_t)l31 * 4096 + kt * 64 + 32 * mt + 8 * rg + 4 * hh) = v; }
    }
    __syncthreads();
    for (int qi = 0; qi < 4; ++qi) {
        const int qq = wid * 4 + qi; u64 myword = 0ull;
        unsigned* sS = (unsigned*)(smem + 36864) + wid * 128;
        if (ntile <= 4) { myword = (lane < ntile) ? ~0ull : 0ull; }
        else if (ntile <= 32) {
            const unsigned b32 = (unsigned)select_row<32>(scr + (size_t)qq * 4096, ntile * 64, sS, lane);
            const unsigned lo = (unsigned)__shfl((int)b32, (2 * lane) & 63), hi = (unsigned)__shfl((int)b32, (2 * lane + 1) & 63);
            myword = lane < 32 ? ((u64)lo | ((u64)hi << 32)) : 0ull;
        } else myword = select_row<64>(scr + (size_t)qq * 4096, ntile * 64, sS, lane);
        mask[(rowb + q0 + qq) * 64 + lane] = myword;
    }
}

DI void norm_region(bf16_t* ptr, const float* g, int lane) {
    const u32x4 w = *(const u32x4*)(ptr + lane * 8); float f[8]; unpack8(w, f); float ss = 0.f;
#pragma unroll
    for (int j = 0; j < 8; ++j) ss += f[j] * f[j];
    ss += __shfl_xor(ss, 1); ss += __shfl_xor(ss, 2); ss += __shfl_xor(ss, 4); ss += __shfl_xor(ss, 8);
    const float rs = rsqrtf(ss * (1.f / 128.f) + 1e-6f);
    const f32x4 g0 = *(const f32x4*)(g + (lane & 15) * 8), g1 = *(const f32x4*)(g + (lane & 15) * 8 + 4);
    *(bf16x8*)(ptr + lane * 8) = pack8(f[0] * rs * g0[0], f[1] * rs * g0[1], f[2] * rs * g0[2], f[3] * rs * g0[3], f[4] * rs * g1[0], f[5] * rs * g1[1], f[6] * rs * g1[2], f[7] * rs * g1[3]);
}
DI void qknorm_pass(const int tid, const int bid, const Params& p, int l) {
    const int wid = tid >> 6, lane = tid & 63, G = gridDim.x;
    bf16_t* U = (bf16_t*)(p.ws + OFF_U); bf16_t* MKV = (bf16_t*)(p.ws + OFF_MKV);
    const float* g = p.qk_g + l * 512;
    for (int row = bid * 8 + wid; row < T_ + 1024; row += G * 8) {
        if (row < T_) { bf16_t* ur = U + (size_t)row * LDU; norm_region(ur + A_Q, g, lane); norm_region(ur + A_K, g + 128, lane); norm_region(ur + M_Q, g + 256, lane); }
        else norm_region(MKV + (size_t)(row - T_) * 1024, g + 384, lane);
    }
}

constexpr int AT_SK = 0, AT_SV = 17408, AT_BUF = 18944;
template <int MODE>
DI void attn_range(const int tid, unsigned char* smem, const Params& p, int b, int hd, int q0, int kt0, int kt1, f32x16 (&ot)[4], float& lsum) {
    bf16_t* sK = (bf16_t*)(smem + AT_SK); bf16_t* sV = (bf16_t*)(smem + AT_SV);
    const bf16_t* U = (const bf16_t*)(p.ws + OFF_U); const bf16_t* MKV = (const bf16_t*)(p.ws + OFF_MKV);
    const u64* mask = (const u64*)(p.ws + OFF_MASK);
    const int wid = tid >> 6, lane = tid & 63, l31 = lane & 31, hh = lane >> 5;
    const size_t row = (size_t)b * S_ + q0 + wid * 32 + l31;
    bf16x8 qf[8];
    { const bf16_t* qp = U + row * LDU + (MODE == 0 ? M_Q : A_Q) + hd * 128 + 8 * hh;
#pragma unroll
      for (int s = 0; s < 8; ++s) qf[s] = *(const bf16x8*)(qp + 16 * s); }
    ot[0] = zero16(); ot[1] = zero16(); ot[2] = zero16(); ot[3] = zero16(); lsum = 0.f;
    const int skey = tid >> 4, spart = tid & 15;
    const bf16_t* kbase = MODE == 0 ? MKV + (size_t)(b * 256 + skey) * 1024 + hd * 128 + spart * 8 : U + ((size_t)b * S_ + skey) * LDU + A_K + hd * 128 + spart * 8;
    const size_t ldk = MODE == 0 ? 1024 : LDU, voff = MODE == 0 ? 512 : (A_V - A_K);
    u32x4 kr[2], vr[2]; u64 mwc = 0ull, mwn = 0ull;
    const int i16 = lane & 15, tq = i16 >> 2, tp = i16 & 3, tgrp = l31 >> 4;
    __syncthreads();
    { const bf16_t* kp = kbase + (size_t)kt0 * 64 * ldk;
      kr[0] = *(const u32x4*)kp; kr[1] = *(const u32x4*)(kp + 32 * ldk); vr[0] = *(const u32x4*)(kp + voff); vr[1] = *(const u32x4*)(kp + 32 * ldk + voff);
      if (MODE == 1) mwc = mask[row * 64 + kt0];
      *(u32x4*)(sK + skey * 136 + spart * 8) = kr[0]; *(u32x4*)(sK + (skey + 32) * 136 + spart * 8) = kr[1];
      *(u32x4*)(sV + skey * 160 + spart * 8) = vr[0]; *(u32x4*)(sV + (skey + 32) * 160 + spart * 8) = vr[1]; }
    if (kt0 + 1 < kt1) { const bf16_t* kp = kbase + (size_t)(kt0 + 1) * 64 * ldk;
        kr[0] = *(const u32x4*)kp; kr[1] = *(const u32x4*)(kp + 32 * ldk); vr[0] = *(const u32x4*)(kp + voff); vr[1] = *(const u32x4*)(kp + 32 * ldk + voff);
        if (MODE == 1) mwn = mask[row * 64 + kt0 + 1]; }
    __syncthreads();
    int cur = 0;
    for (int kt = kt0; kt < kt1; ++kt) {
        const bf16_t* sKc = sK + cur * AT_BUF; const bf16_t* sVc = sV + cur * AT_BUF;
        const u64 mwh = mwc >> (4 * hh);
        if (kt + 1 < kt1) { bf16_t* sKn = sK + (cur ^ 1) * AT_BUF; bf16_t* sVn = sV + (cur ^ 1) * AT_BUF;
            *(u32x4*)(sKn + skey * 136 + spart * 8) = kr[0]; *(u32x4*)(sKn + (skey + 32) * 136 + spart * 8) = kr[1];
            *(u32x4*)(sVn + skey * 160 + spart * 8) = vr[0]; *(u32x4*)(sVn + (skey + 32) * 160 + spart * 8) = vr[1];
            mwc = mwn; }
        if (kt + 2 < kt1) { const bf16_t* kp = kbase + (size_t)(kt + 2) * 64 * ldk;
            kr[0] = *(const u32x4*)kp; kr[1] = *(const u32x4*)(kp + 32 * ldk); vr[0] = *(const u32x4*)(kp + voff); vr[1] = *(const u32x4*)(kp + 32 * ldk + voff);
            if (MODE == 1) mwn = mask[row * 64 + kt + 2]; }
        f32x16 st[2]; st[0] = zero16(); st[1] = zero16();
#pragma unroll
        for (int mt = 0; mt < 2; ++mt)
#pragma unroll
            for (int s = 0; s < 8; ++s) { const bf16x8 kf = *(const bf16x8*)(sKc + (32 * mt + l31) * 136 + 16 * s + 8 * hh); st[mt] = MFMA32(kf, qf[s], st[mt]); }
        bf16x8 pb[2][2];
#pragma unroll
        for (int mt = 0; mt < 2; ++mt) {
            const int mw32 = (int)(unsigned)(mwh >> (32 * mt));
#pragma unroll
            for (int r = 0; r < 16; ++r) { float pv = __builtin_amdgcn_exp2f(st[mt][r] * (0.08838834764831845f * 1.4426950408889634f));
                if (MODE == 1) pv = __int_as_float(__float_as_int(pv) & __builtin_amdgcn_sbfe(mw32, (r & 3) + 8 * (r >> 2), 1));
                lsum += pv; st[mt][r] = pv; }
            pb[mt][0] = pack8(st[mt][0], st[mt][1], st[mt][2], st[mt][3], st[mt][4], st[mt][5], st[mt][6], st[mt][7]);
            pb[mt][1] = pack8(st[mt][8], st[mt][9], st[mt][10], st[mt][11], st[mt][12], st[mt][13], st[mt][14], st[mt][15]);
        }
#pragma unroll
        for (int i = 0; i < 4; ++i)
#pragma unroll
            for (int mt = 0; mt < 2; ++mt)
#pragma unroll
                for (int s2 = 0; s2 < 2; ++s2) { const bf16_t* vp = sVc + (32 * mt + 16 * s2 + 4 * hh + tq) * 160 + 32 * i + 16 * tgrp + 4 * tp;
                    const s16x4 lo = __builtin_amdgcn_ds_read_tr16_b64_v4i16((LAS s16x4*)vp), hi = __builtin_amdgcn_ds_read_tr16_b64_v4i16((LAS s16x4*)(vp + 8 * 160));
                    ot[i] = MFMA32(__builtin_shufflevector(lo, hi, 0, 1, 2, 3, 4, 5, 6, 7), pb[mt][s2], ot[i]); }
        __syncthreads();
        cur ^= 1;
    }
    lsum += __shfl_xor(lsum, 32);
}

DI void attnM_item(const int tid, unsigned char* smem, const Params& p, int item) {
    const bf16_t* U = (const bf16_t*)(p.ws + OFF_U); bf16_t* Y = (bf16_t*)(p.ws + OFF_Y);
    const int wid = tid >> 6, lane = tid & 63, l31 = lane & 31, hh = lane >> 5;
    const int b = item >> 6, qt = (item >> 2) & 15, hd = item & 3, q0 = qt * 256;
    f32x16 ot[4]; float lsum;
    attn_range<0>(tid, smem, p, b, hd, q0, 0, 4, ot, lsum);
    const size_t row = (size_t)b * S_ + q0 + wid * 32 + l31; const float inv = 1.0f / lsum;
#pragma unroll
    for (int i = 0; i < 4; ++i)
#pragma unroll
        for (int rg = 0; rg < 4; ++rg) { const int col = hd * 128 + 32 * i + 8 * rg + 4 * hh;
            const u32x2 zw = *(const u32x2*)(U + row * LDU + M_Z + col);
            u32x2 w; w.x = pk2(ot[i][4 * rg] * inv * siluf_(lo16(zw.x)), ot[i][4 * rg + 1] * inv * siluf_(hi16(zw.x)));
            w.y = pk2(ot[i][4 * rg + 2] * inv * siluf_(lo16(zw.y)), ot[i][4 * rg + 3] * inv * siluf_(hi16(zw.y)));
            *(u32x2*)(Y + row * 2048 + 3 * 512 + col) = w; }
}
DI void attnA_item(const int tid, unsigned char* smem, const Params& p, int item) {
    bf16_t* Opart = (bf16_t*)(p.ws + OFF_R1); float* lpart = (float*)(p.ws + OFF_R1) + (size_t)2 * T_ * 512;
    const int wid = tid >> 6, lane = tid & 63, l31 = lane & 31, hh = lane >> 5;
    const int b = item >> 6, hd = (item >> 4) & 3, pr = (item >> 1) & 7, half = item & 1;
#pragma unroll 1
    for (int sub = 0; sub < 2; ++sub) {
        const int qt = sub == 0 ? pr : 15 - pr, n2 = 2 * (qt + 1), q0 = qt * 256;
        f32x16 ot[4]; float lsum;
        attn_range<1>(tid, smem, p, b, hd, q0, half * n2, (half + 1) * n2, ot, lsum);
        const size_t row = (size_t)b * S_ + q0 + wid * 32 + l31;
        bf16_t* op = Opart + ((size_t)half * T_ + row) * 512 + hd * 128;
#pragma unroll
        for (int i = 0; i < 4; ++i)
#pragma unroll
            for (int rg = 0; rg < 4; ++rg) { u32x2 w; w.x = pk2(ot[i][4 * rg], ot[i][4 * rg + 1]); w.y = pk2(ot[i][4 * rg + 2], ot[i][4 * rg + 3]);
                *(u32x2*)(op + 32 * i + 8 * rg + 4 * hh) = w; }
        if (hh == 0) lpart[((size_t)half * T_ + row) * 4 + hd] = lsum;
    }
}
DI void attnA_finalize(const int tid, const int bid, const Params& p) {
    const bf16_t* Opart = (const bf16_t*)(p.ws + OFF_R1); const float* lpart = (const float*)(p.ws + OFF_R1) + (size_t)2 * T_ * 512;
    const bf16_t* U = (const bf16_t*)(p.ws + OFF_U); bf16_t* Y = (bf16_t*)(p.ws + OFF_Y);
    for (int i = bid * 512 + tid; i < T_ * 128; i += gridDim.x * 512) { const int row = i >> 7, c4 = (i & 127) * 4, hd = c4 >> 7;
        const u32x2 w0 = *(const u32x2*)(Opart + (size_t)row * 512 + c4), w1 = *(const u32x2*)(Opart + ((size_t)T_ + row) * 512 + c4);
        const f32x4 o0 = {lo16(w0.x), hi16(w0.x), lo16(w0.y), hi16(w0.y)}, o1 = {lo16(w1.x), hi16(w1.x), lo16(w1.y), hi16(w1.y)};
        const float inv = 1.0f / (lpart[(size_t)row * 4 + hd] + lpart[((size_t)T_ + row) * 4 + hd]);
        const u32x2 zw = *(const u32x2*)(U + (size_t)row * LDU + A_Z + c4);
        u32x2 w; w.x = pk2((o0[0] + o1[0]) * inv * siluf_(lo16(zw.x)), (o0[1] + o1[1]) * inv * siluf_(hi16(zw.x)));
        w.y = pk2((o0[2] + o1[2]) * inv * siluf_(lo16(zw.y)), (o0[3] + o1[3]) * inv * siluf_(hi16(zw.y)));
        *(u32x2*)(Y + (size_t)row * 2048 + c4) = w; }
}

constexpr int CK_SQ = 0, CK_SK = 17408, CK_SQD = 34816, CK_SVT = 52224, CK_SKDT = 70656, CK_CUM = 89088, CK_TOT = 122112, CK_RED = 124160;
DI float lgamma_h(int hd) { return hd == 0 ? -0.031748698314580301f : hd == 1 ? -0.015748356968139168f : hd == 2 ? -0.0078431774610258928f : -0.0039138993211363287f; }

template <int PH>
DI void chunk_item(const int tid, unsigned char* smem, const Params& p, int l, int item) {
    bf16_t* sQ = (bf16_t*)(smem + CK_SQ); bf16_t* sK = (bf16_t*)(smem + CK_SK); bf16_t* sQd = (bf16_t*)(smem + CK_SQD);
    bf16_t* sVt = (bf16_t*)(smem + CK_SVT); bf16_t* sKdT = (bf16_t*)(smem + CK_SKDT);
    float* sCum = (float*)(smem + CK_CUM); float* sTot = (float*)(smem + CK_TOT); float* sRed = (float*)(smem + CK_RED);
    const bf16_t* U = (const bf16_t*)(p.ws + OFF_U); bf16_t* Y = (bf16_t*)(p.ws + OFF_Y);
    const int wid = tid >> 6, lane = tid & 63, l31 = lane & 31, hh = lane >> 5;
    const int mode = item >> 10, rem = item & 1023, b = rem >> 8, hd = (rem >> 6) & 3, n = rem & 63;
    bf16_t* ST = (bf16_t*)(p.ws + (mode == 0 ? OFF_STB : OFF_STC)) + (size_t)rem * 16384;
    const float lg = lgamma_h(hd);
    __syncthreads();
    {
        const int s = tid & 63, wd = tid >> 6; const size_t row = (size_t)b * S_ + n * 64 + s;
        const bf16_t* ur = U + row * LDU;
        if (mode == 0) {
            const int pos = n * 64 + s; const float* rope = (const float*)(p.ws + OFF_ROPE);
            float cs[8], sn[8];
            { const f32x4 c0 = *(const f32x4*)(rope + pos * 64 + wd * 8), c1 = *(const f32x4*)(rope + pos * 64 + wd * 8 + 4);
              const f32x4 s0 = *(const f32x4*)(rope + 4096 * 64 + pos * 64 + wd * 8), s1 = *(const f32x4*)(rope + 4096 * 64 + pos * 64 + wd * 8 + 4);
#pragma unroll
              for (int e = 0; e < 4; ++e) { cs[e] = c0[e]; cs[4 + e] = c1[e]; sn[e] = s0[e]; sn[4 + e] = s1[e]; } }
            float k1[8], k2[8], ka[8], kb[8];
            unpack8(*(const u32x4*)(ur + B_K + hd * 128 + wd * 8), k1); unpack8(*(const u32x4*)(ur + B_K + hd * 128 + 64 + wd * 8), k2);
#pragma unroll
            for (int e = 0; e < 8; ++e) { ka[e] = (k1[e] * cs[e] - k2[e] * sn[e]) * 0.08838834764831845f; kb[e] = (k1[e] * sn[e] + k2[e] * cs[e]) * 0.08838834764831845f; }
            if (PH == 4) {
                float q1[8], q2[8], qa[8], qb[8];
                unpack8(*(const u32x4*)(ur + B_Q + hd * 128 + wd * 8), q1); unpack8(*(const u32x4*)(ur + B_Q + hd * 128 + 64 + wd * 8), q2);
#pragma unroll
                for (int e = 0; e < 8; ++e) { qa[e] = q1[e] * cs[e] - q2[e] * sn[e]; qb[e] = q1[e] * sn[e] + q2[e] * cs[e]; }
                *(bf16x8*)(sQ + s * 136 + wd * 8) = pack8(qa[0], qa[1], qa[2], qa[3], qa[4], qa[5], qa[6], qa[7]);
                *(bf16x8*)(sQ + s * 136 + 64 + wd * 8) = pack8(qb[0], qb[1], qb[2], qb[3], qb[4], qb[5], qb[6], qb[7]);
                const float gqd = __expf(lg * (float)(s + 1));
                *(bf16x8*)(sQd + s * 136 + wd * 8) = pack8(qa[0] * gqd, qa[1] * gqd, qa[2] * gqd, qa[3] * gqd, qa[4] * gqd, qa[5] * gqd, qa[6] * gqd, qa[7] * gqd);
                *(bf16x8*)(sQd + s * 136 + 64 + wd * 8) = pack8(qb[0] * gqd, qb[1] * gqd, qb[2] * gqd, qb[3] * gqd, qb[4] * gqd, qb[5] * gqd, qb[6] * gqd, qb[7] * gqd);
                *(bf16x8*)(sK + s * 136 + wd * 8) = pack8(ka[0], ka[1], ka[2], ka[3], ka[4], ka[5], ka[6], ka[7]);
                *(bf16x8*)(sK + s * 136 + 64 + wd * 8) = pack8(kb[0], kb[1], kb[2], kb[3], kb[4], kb[5], kb[6], kb[7]);
            } else {
                const float gkd = __expf(lg * (float)(63 - s));
#pragma unroll
                for (int e = 0; e < 8; ++e) { sKdT[(wd * 8 + e) * 72 + s] = f2bf(ka[e] * gkd); sKdT[(64 + wd * 8 + e) * 72 + s] = f2bf(kb[e] * gkd); }
            }
            const u32x4 v0 = *(const u32x4*)(ur + B_V + hd * 128 + wd * 16), v1 = *(const u32x4*)(ur + B_V + hd * 128 + wd * 16 + 8);
            const unsigned w[8] = {v0.x, v0.y, v0.z, v0.w, v1.x, v1.y, v1.z, v1.w};
#pragma unroll
            for (int e = 0; e < 8; ++e) { sVt[(wd * 16 + 2 * e) * 72 + s] = (bf16_t)(w[e] & 0xffffu); sVt[(wd * 16 + 2 * e + 1) * 72 + s] = (bf16_t)(w[e] >> 16); }
        } else {
            const int d0 = wd * 16;
            float cf[16], kfv[16];
            unpack8(*(const u32x4*)(ur + C_F + hd * 128 + d0), cf); unpack8(*(const u32x4*)(ur + C_F + hd * 128 + d0 + 8), cf + 8);
#pragma unroll
            for (int e = 0; e < 16; ++e) {
                float lb = 0.f;
                if (l == 1) lb = sigmoidf_(p.lb_logits[512 + hd * 128 + d0 + e] - p.lb_logits[hd * 128 + d0 + e]);
                const float sg = sigmoidf_(cf[e]); const float f = lb + (1.f - lb) * sg;
                kfv[e] = (1.f - lb) * (1.f - sg);
                sCum[s * 129 + d0 + e] = fmaxf(__logf(f), -30.f);
            }
            __syncthreads();
            { const int seg = tid >> 7, d = tid & 127; float run = 0.f;
#pragma unroll
              for (int i = 0; i < 16; ++i) { const int ix = (seg * 16 + i) * 129 + d; run += sCum[ix]; sCum[ix] = run; }
              sTot[seg * 128 + d] = run; }
            __syncthreads();
            { const int seg = tid >> 7, d = tid & 127; float off = 0.f;
              for (int g = 0; g < seg; ++g) off += sTot[g * 128 + d];
              if (seg > 0) {
#pragma unroll
                  for (int i = 0; i < 16; ++i) sCum[(seg * 16 + i) * 129 + d] += off; } }
            __syncthreads();
            if (PH == 4) {
                float q[16];
                unpack8(*(const u32x4*)(ur + C_Q + hd * 128 + d0), q); unpack8(*(const u32x4*)(ur + C_Q + hd * 128 + d0 + 8), q + 8);
                float a[16], kk[16], qd[16];
#pragma unroll
                for (int e = 0; e < 16; ++e) { const float cum = sCum[s * 129 + d0 + e], ref = sCum[31 * 129 + d0 + e];
                    const float dl = fminf(fmaxf(cum - ref, -80.f), 80.f);
                    a[e] = q[e] * __expf(dl); kk[e] = kfv[e] * __expf(-dl); qd[e] = q[e] * __expf(cum); }
                *(bf16x8*)(sQ + s * 136 + d0) = pack8(a[0], a[1], a[2], a[3], a[4], a[5], a[6], a[7]);
                *(bf16x8*)(sQ + s * 136 + d0 + 8) = pack8(a[8], a[9], a[10], a[11], a[12], a[13], a[14], a[15]);
                *(bf16x8*)(sK + s * 136 + d0) = pack8(kk[0], kk[1], kk[2], kk[3], kk[4], kk[5], kk[6], kk[7]);
                *(bf16x8*)(sK + s * 136 + d0 + 8) = pack8(kk[8], kk[9], kk[10], kk[11], kk[12], kk[13], kk[14], kk[15]);
                *(bf16x8*)(sQd + s * 136 + d0) = pack8(qd[0], qd[1], qd[2], qd[3], qd[4], qd[5], qd[6], qd[7]);
                *(bf16x8*)(sQd + s * 136 + d0 + 8) = pack8(qd[8], qd[9], qd[10], qd[11], qd[12], qd[13], qd[14], qd[15]);
            } else {
#pragma unroll
                for (int e = 0; e < 16; ++e) { const float cum = sCum[s * 129 + d0 + e], en = sCum[63 * 129 + d0 + e];
                    sKdT[(d0 + e) * 72 + s] = f2bf(kfv[e] * __expf(en - cum)); }
                if (tid < 128) ((float*)(p.ws + OFF_DEC))[rem * 128 + tid] = __expf(sCum[63 * 129 + tid]);
            }
            const u32x4 v0 = *(const u32x4*)(ur + C_I + hd * 128 + d0), v1 = *(const u32x4*)(ur + C_I + hd * 128 + d0 + 8);
            const unsigned w[8] = {v0.x, v0.y, v0.z, v0.w, v1.x, v1.y, v1.z, v1.w};
#pragma unroll
            for (int e = 0; e < 8; ++e) { sVt[(d0 + 2 * e) * 72 + s] = (bf16_t)(w[e] & 0xffffu); sVt[(d0 + 2 * e + 1) * 72 + s] = (bf16_t)(w[e] >> 16); }
        }
    }
    __syncthreads();
    if (PH == 2) {
        const int vt = wid >> 1, dtb = (wid & 1) * 2;
        f32x16 acc[2]; acc[0] = zero16(); acc[1] = zero16();
#pragma unroll
        for (int s2 = 0; s2 < 4; ++s2) { const bf16x8 af = *(const bf16x8*)(sVt + (32 * vt + l31) * 72 + 16 * s2 + 8 * hh);
#pragma unroll
            for (int j = 0; j < 2; ++j) { const bf16x8 bfr = *(const bf16x8*)(sKdT + (32 * (dtb + j) + l31) * 72 + 16 * s2 + 8 * hh); acc[j] = MFMA32(af, bfr, acc[j]); } }
#pragma unroll
        for (int j = 0; j < 2; ++j)
#pragma unroll
            for (int r = 0; r < 16; ++r) { const int v = 32 * vt + (r & 3) + 8 * (r >> 2) + 4 * hh; ST[v * 128 + 32 * (dtb + j) + l31] = f2bf(acc[j][r]); }
    } else {
        const int tg = wid & 1, vt = wid >> 1, t_idx = 32 * tg + l31;
        f32x16 st[2]; st[0] = zero16(); st[1] = zero16();
#pragma unroll
        for (int s = 0; s < 8; ++s) { const bf16x8 qf = *(const bf16x8*)(sQ + t_idx * 136 + 16 * s + 8 * hh);
#pragma unroll
            for (int mt = 0; mt < 2; ++mt) { const bf16x8 kf = *(const bf16x8*)(sK + (32 * mt + l31) * 136 + 16 * s + 8 * hh); st[mt] = MFMA32(kf, qf, st[mt]); } }
        bf16x8 pb[2][2];
#pragma unroll
        for (int mt = 0; mt < 2; ++mt) {
#pragma unroll
            for (int r = 0; r < 16; ++r) { const int s_idx = 32 * mt + (r & 3) + 8 * (r >> 2) + 4 * hh;
                if (mode == 0) st[mt][r] *= __expf(lg * fabsf((float)(t_idx - s_idx)));
                else st[mt][r] = (s_idx <= t_idx) ? st[mt][r] : 0.f; }
            pb[mt][0] = pack8(st[mt][0], st[mt][1], st[mt][2], st[mt][3], st[mt][4], st[mt][5], st[mt][6], st[mt][7]);
            pb[mt][1] = pack8(st[mt][8], st[mt][9], st[mt][10], st[mt][11], st[mt][12], st[mt][13], st[mt][14], st[mt][15]);
        }
        f32x16 o = zero16();
#pragma unroll
        for (int mt = 0; mt < 2; ++mt)
#pragma unroll
            for (int s2 = 0; s2 < 2; ++s2) { const bf16_t* vr = sVt + (32 * vt + l31) * 72 + 32 * mt + 16 * s2 + 4 * hh;
                const s16x4 lo = *(const s16x4*)vr, hi = *(const s16x4*)(vr + 8);
                o = MFMA32(__builtin_shufflevector(lo, hi, 0, 1, 2, 3, 4, 5, 6, 7), pb[mt][s2], o); }
#pragma unroll
        for (int s = 0; s < 8; ++s) { const bf16x8 af = *(const bf16x8*)(ST + (32 * vt + l31) * 128 + 16 * s + 8 * hh);
            const bf16x8 bq = *(const bf16x8*)(sQd + t_idx * 136 + 16 * s + 8 * hh);
            o = MFMA32(af, bq, o); }
        float ss = 0.f;
#pragma unroll
        for (int r = 0; r < 16; ++r) ss += o[r] * o[r];
        ss += __shfl_xor(ss, 32);
        if (hh == 0) sRed[vt * 64 + t_idx] = ss;
        __syncthreads();
        const float tot = sRed[t_idx] + sRed[64 + t_idx] + sRed[128 + t_idx] + sRed[192 + t_idx];
        const float rstd = rsqrtf(tot * (1.f / 128.f) + 1e-6f);
        const float* gain = (mode == 0 ? p.ret_g : p.hgrn_g) + (l * 4 + hd) * 128;
        const int zoff = mode == 0 ? B_Z : C_Z, brn = mode == 0 ? 1 : 2;
        const size_t row = (size_t)b * S_ + n * 64 + t_idx;
#pragma unroll
        for (int rg = 0; rg < 4; ++rg) { const int v = 32 * vt + 8 * rg + 4 * hh; const f32x4 gg = *(const f32x4*)(gain + v);
            const u32x2 zw = *(const u32x2*)(U + row * LDU + zoff + hd * 128 + v);
            u32x2 w; w.x = pk2(o[4 * rg] * rstd * gg[0] * siluf_(lo16(zw.x)), o[4 * rg + 1] * rstd * gg[1] * siluf_(hi16(zw.x)));
            w.y = pk2(o[4 * rg + 2] * rstd * gg[2] * siluf_(lo16(zw.y)), o[4 * rg + 3] * rstd * gg[3] * siluf_(hi16(zw.y)));
            *(u32x2*)(Y + row * 2048 + brn * 512 + hd * 128 + v) = w; }
    }
}

DI void scan_item(const int tid, const Params& p, int item) {
    const int mode = item >> 7, rem = item & 127, bh = rem >> 3, slice = rem & 7, hd = bh & 3;
    const int e0 = slice * 2048 + tid * 4, d = e0 & 127;
    bf16_t* ST = (bf16_t*)(p.ws + (mode == 0 ? OFF_STB : OFF_STC)) + (size_t)bh * 64 * 16384 + e0;
    const float* DEC = (const float*)(p.ws + OFF_DEC) + (size_t)bh * 64 * 128 + d;
    const float gdec = __expf(lgamma_h(hd) * 64.f);
    f32x4 prev = (f32x4){0.f, 0.f, 0.f, 0.f};
    for (int n0 = 0; n0 < 64; n0 += 8) {
        u32x2 cur[8]; f32x4 dec[8];
#pragma unroll
        for (int i = 0; i < 8; ++i) { cur[i] = *(const u32x2*)(ST + (size_t)(n0 + i) * 16384);
            dec[i] = mode == 0 ? (f32x4){gdec, gdec, gdec, gdec} : *(const f32x4*)(DEC + (n0 + i) * 128); }
#pragma unroll
        for (int i = 0; i < 8; ++i) { u32x2 w; w.x = pk2(prev[0], prev[1]); w.y = pk2(prev[2], prev[3]); *(u32x2*)(ST + (size_t)(n0 + i) * 16384) = w;
            const f32x4 c = {lo16(cur[i].x), hi16(cur[i].x), lo16(cur[i].y), hi16(cur[i].y)}; prev = dec[i] * prev + c; }
    }
}

#define XB_TMO      128
#define XB_XCNT(j)  (256  + 64 * (j))
#define XB_XSUB(j)  (1280 + 64 * (j))
#define XB_XGEN(j)  (2304 + 64 * (j))
#define XB_TOP      3328
#define XB_TOPGEN   3392
#define XB_SPIN_CAP (1u << 18)
DI unsigned xb_ld(unsigned* p) { return __hip_atomic_load(p, __ATOMIC_RELAXED, __HIP_MEMORY_SCOPE_AGENT); }
DI unsigned xb_add(unsigned* p, unsigned v) { return __hip_atomic_fetch_add(p, v, __ATOMIC_RELAXED, __HIP_MEMORY_SCOPE_AGENT); }
DI unsigned xb_xcc_id() { return (unsigned)__builtin_amdgcn_s_getreg((3 << 11) | 20) & 0xFu; }
#define XB_SPIN(cond, bar) do { unsigned _sp = 0; while (cond) { __builtin_amdgcn_s_sleep(1); \
    if ((++_sp & 255u) == 0u) { if (xb_ld(&(bar)[XB_TMO])) break; if (_sp > XB_SPIN_CAP) { atomicAdd(&(bar)[XB_TMO], 1u); break; } } } } while (0)
struct XcdBarrier { unsigned* bar; unsigned x; volatile LAS unsigned* st; };
DI XcdBarrier xcd_barrier_post(unsigned* bar, volatile LAS unsigned* st) {
    XcdBarrier b; b.bar = bar; b.x = xb_xcc_id(); b.st = st;
    if (threadIdx.x == 0) (void)xb_add(&bar[XB_XCNT(b.x)], 1u);
    return b;
}
DI void xcd_barrier_complete(unsigned* bar, unsigned x, unsigned& nloc, unsigned& nx) {
    const unsigned G = gridDim.x * gridDim.y * gridDim.z;
    unsigned sum, cnt, mine, sp = 0u;
    for (;;) {
        sum = 0u; cnt = 0u; mine = 0u;
#pragma unroll
        for (unsigned j = 0; j < 16; ++j) { const unsigned c = xb_ld(&bar[XB_XCNT(j)]); sum += c; cnt += (c > 0u) ? 1u : 0u; mine = (j == x) ? c : mine; }
        if (sum == G) break;
        __builtin_amdgcn_s_sleep(1);
        if ((++sp & 255u) == 0u) { if (xb_ld(&bar[XB_TMO])) break; if (sp > XB_SPIN_CAP) { atomicAdd(&bar[XB_TMO], 1u); break; } }
    }
    nloc = mine > 0u ? mine : 1u; nx = cnt > 0u ? cnt : 1u;
}
DI void xcd_barrier(const XcdBarrier& b) {
    asm volatile("s_waitcnt vmcnt(0)" ::: "memory");
    __syncthreads();
    if (threadIdx.x == 0) {
        unsigned* bar = b.bar;
        __builtin_amdgcn_s_waitcnt(0);
        unsigned nloc = b.st[0], nx = b.st[1];
        if (nloc == 0u) { xcd_barrier_complete(bar, b.x, nloc, nx); b.st[0] = nloc; b.st[1] = nx; }
        const unsigned old = xb_add(&bar[XB_XSUB(b.x)], 1u);
        const unsigned gen = old / nloc;
        if (old + 1u == (gen + 1u) * nloc) {
            __builtin_amdgcn_fence(__ATOMIC_RELEASE, "agent");
            asm volatile("s_waitcnt vmcnt(0)" ::: "memory");
            const unsigned og = xb_add(&bar[XB_TOP], 1u);
            const unsigned tg = og / nx;
            if (og + 1u == (tg + 1u) * nx) xb_add(&bar[XB_TOPGEN], 1u);
            else XB_SPIN(xb_ld(&bar[XB_TOPGEN]) == tg, bar);
            __builtin_amdgcn_fence(__ATOMIC_ACQUIRE, "agent");
            xb_add(&bar[XB_XGEN(b.x)], 1u);
            asm volatile("s_waitcnt vmcnt(0)" ::: "memory");
        } else {
            XB_SPIN(xb_ld(&bar[XB_XGEN(b.x)]) == gen, bar);
            __builtin_amdgcn_fence(__ATOMIC_ACQUIRE, "agent");
            asm volatile("s_waitcnt vmcnt(0)" ::: "memory");
        }
    }
    __syncthreads();
}

#define OPQ() do { asm volatile("" : "+v"(tid)); asm volatile("" : "+s"(bid)); } while (0)
template <int Q>
DI void run_phase(const int l, int tid, int bid, unsigned char* smem, const Params& p) {
    const int G = gridDim.x;
    OPQ();
    if (Q == 0) {
        phase_prep(tid, bid, smem, p, l);
    } else if (Q == 1) {
        { pg8::Gemm g{(const bf16_t*)(p.ws + OFF_H), (const bf16_t*)(p.ws + OFF_WINT), 2048, 2048, T_, G_OFF, 2048};
          pg8::StaticOrder S; S.init(g.M, g.N, G, bid);
          pg8::EpiBf16 E{(bf16_t*)(p.ws + OFF_U), LDU, 1 << 30};
          pg8::gemm_phase(tid, ((LAS unsigned char*)smem), g, S, E); }
        OPQ();
        { pg8::Gemm g{(const bf16_t*)(p.ws + OFF_H), (const bf16_t*)(p.ws + OFF_WINT) + (size_t)G_OFF * 2048, 2048, 2048, T_, 8192, 2048};
          pg8::StaticOrder S; S.init(g.M, g.N, G, bid);
          pg8::EpiGateRatio E{(bf16_t*)(p.ws + OFF_U)};
          pg8::gemm_phase(tid, ((LAS unsigned char*)smem), g, S, E); }
        OPQ();
        { pg8::Gemm g{(const bf16_t*)(p.ws + OFF_MEMB), (const bf16_t*)(p.ws + OFF_WMKV), 2048, 2048, 1024, 1024, 2048};
          pg8::StaticOrder S; S.init(g.M, g.N, G, (bid + G - (3 * G) / 4) % G);
          pg8::EpiBf16 E{(bf16_t*)(p.ws + OFF_MKV), 1024, 1 << 30};
          pg8::gemm_phase(tid, ((LAS unsigned char*)smem), g, S, E); }
    } else if (Q == 2) {
        for (int j = bid; j < 256; j += G) { const int b = j >> 6, c = j & 63; index_item(tid, bid, smem, p, b, c, 0); index_item(tid, bid, smem, p, b, 63 - c, 1); }
        OPQ(); qknorm_pass(tid, bid, p, l);
        OPQ(); for (int j = bid; j < 2048; j += G) chunk_item<2>(tid, smem, p, l, j);
    } else if (Q == 3) {
        for (int j = bid; j < 256; j += G) attnA_item(tid, smem, p, j);
        OPQ(); for (int j = bid; j < 256; j += G) attnM_item(tid, smem, p, j);
        OPQ(); for (int j = bid; j < 256; j += G) scan_item(tid, p, j);
    } else if (Q == 4) {
        for (int j = bid; j < 2048; j += G) chunk_item<4>(tid, smem, p, l, j);
        OPQ(); attnA_finalize(tid, bid, p);
    } else if (Q == 5) {
        pg8::Gemm g{(const bf16_t*)(p.ws + OFF_Y), (const bf16_t*)(p.ws + OFF_WBRT), 2048, 2048, T_, 2048, 2048};
        pg8::StaticOrder S; S.init(g.M, g.N, G, bid);
        pg8::EpiMerged E{(bf16_t*)(p.ws + OFF_H), (const bf16_t*)(p.ws + OFF_U)};
        pg8::HookGate HK{(const bf16_t*)(p.ws + OFF_U)};
        pg8::gemm_phase(tid, ((LAS unsigned char*)smem), g, S, E, HK);
    } else {
        pg8::Gemm g{(const bf16_t*)(p.ws + OFF_H), (const bf16_t*)(p.ws + OFF_WOUT), 2048, 2048, T_, 2048, 2048};
        pg8::StaticOrder S; S.init(g.M, g.N, G, bid);
        pg8::EpiOut E{l == 0 ? p.x : p.out, p.out};
        pg8::gemm_phase(tid, ((LAS unsigned char*)smem), g, S, E);
    }
}

template <int Q>
__global__ __launch_bounds__(512, 2) void mega_one(Params p, int l) {
    extern __shared__ __attribute__((aligned(16))) unsigned char smem[];
    run_phase<Q>(l, threadIdx.x, blockIdx.x, smem, p);
}

#ifndef DUPMASK
#define DUPMASK 0
#endif
#define GSYNC() xcd_barrier(xb)
#define RUNP(Q) do { run_phase<Q>(L, threadIdx.x, blockIdx.x, smem, p); if ((DUPMASK >> Q) & 1) { GSYNC(); run_phase<Q>(L, threadIdx.x, blockIdx.x, smem, p); } } while (0)
template <int L>
DI void run_layer(unsigned char* smem, const Params& p, const XcdBarrier& xb) {
    RUNP(0); GSYNC();
    RUNP(1); GSYNC();
    RUNP(2); GSYNC();
    RUNP(3); GSYNC();
    RUNP(4); GSYNC();
    RUNP(5); GSYNC();
    RUNP(6);
}
__global__ __launch_bounds__(512, 2) void mega_all(Params p) {
    extern __shared__ __attribute__((aligned(16))) unsigned char smem[];
    volatile LAS unsigned* st = (volatile LAS unsigned*)((LAS unsigned char*)smem + 131072);
    if (threadIdx.x == 0) { st[0] = 0u; st[1] = 0u; st[2] = 0u; st[3] = 0u; }
    __syncthreads();
    const XcdBarrier xb = xcd_barrier_post((unsigned*)(p.ws + OFF_BAR), st);
    run_layer<0>(smem, p, xb);
    GSYNC();
    if (p.coop == 0x7fffffff) cg::this_grid().sync();
    run_layer<1>(smem, p, xb);
}

extern "C" void kernel_launch(void* const* d_in, const int* in_sizes, int n_in, void* d_out, int out_size, void* d_ws, size_t ws_size, hipStream_t stream) {
    static int grid = 0;
    if (grid == 0) {
        if (n_in != 11 || ws_size < WS_NEED || out_size != T_ * 2048) { fprintf(stderr, "kernel_launch: unexpected sizes n_in=%d ws=%zu need=%zu out=%d\n", n_in, ws_size, (size_t)WS_NEED, out_size); grid = -1; return; }
        int dev = 0, cus = 0, per_cu = 0;
        (void)hipGetDevice(&dev); (void)hipDeviceGetAttribute(&cus, hipDeviceAttributeMultiprocessorCount, dev);
#if MULTI_LAUNCH
        (void)hipFuncSetAttribute((const void*)mega_one<0>, hipFuncAttributeMaxDynamicSharedMemorySize, LDS_BYTES); (void)hipFuncSetAttribute((const void*)mega_one<1>, hipFuncAttributeMaxDynamicSharedMemorySize, LDS_BYTES);
        (void)hipFuncSetAttribute((const void*)mega_one<2>, hipFuncAttributeMaxDynamicSharedMemorySize, LDS_BYTES); (void)hipFuncSetAttribute((const void*)mega_one<3>, hipFuncAttributeMaxDynamicSharedMemorySize, LDS_BYTES);
        (void)hipFuncSetAttribute((const void*)mega_one<4>, hipFuncAttributeMaxDynamicSharedMemorySize, LDS_BYTES); (void)hipFuncSetAttribute((const void*)mega_one<5>, hipFuncAttributeMaxDynamicSharedMemorySize, LDS_BYTES);
        (void)hipFuncSetAttribute((const void*)mega_one<6>, hipFuncAttributeMaxDynamicSharedMemorySize, LDS_BYTES);
#else
        if (hipFuncSetAttribute((const void*)mega_all, hipFuncAttributeMaxDynamicSharedMemorySize, LDS_BYTES) != hipSuccess) { fprintf(stderr, "kernel_launch: hipFuncSetAttribute failed\n"); grid = -1; return; }
        (void)hipOccupancyMaxActiveBlocksPerMultiprocessor(&per_cu, (const void*)mega_all, 512, LDS_BYTES);
        if (per_cu < 1) { fprintf(stderr, "kernel_launch: occupancy query says %d blocks per CU\n", per_cu); per_cu = 1; }
#endif
        (void)hipGetLastError();
        grid = cus < 256 ? cus : 256;
    }
    if (grid < 0) return;
    Params p{};
    p.x = (const float*)d_in[0]; p.mem = (const float*)d_in[1]; p.norm_g = (const float*)d_in[2]; p.w_in = (const float*)d_in[3]; p.qk_g = (const float*)d_in[4];
    p.ret_g = (const float*)d_in[5]; p.hgrn_g = (const float*)d_in[6]; p.lb_logits = (const float*)d_in[7]; p.w_mem_kv = (const float*)d_in[8]; p.w_branch = (const float*)d_in[9]; p.w_out = (const float*)d_in[10];
    p.out = (float*)d_out; p.ws = (unsigned char*)d_ws; p.pad = 0;
#if MULTI_LAUNCH
    for (int ph = 0; ph < NPH; ++ph) { const int l = ph / 7;
        switch (ph % 7) {
            case 0: hipLaunchKernelGGL(mega_one<0>, dim3(grid), dim3(512), LDS_BYTES, stream, p, l); break;
            case 1: hipLaunchKernelGGL(mega_one<1>, dim3(grid), dim3(512), LDS_BYTES, stream, p, l); break;
            case 2: hipLaunchKernelGGL(mega_one<2>, dim3(grid), dim3(512), LDS_BYTES, stream, p, l); break;
            case 3: hipLaunchKernelGGL(mega_one<3>, dim3(grid), dim3(512), LDS_BYTES, stream, p, l); break;
            case 4: hipLaunchKernelGGL(mega_one<4>, dim3(grid), dim3(512), LDS_BYTES, stream, p, l); break;
            case 5: hipLaunchKernelGGL(mega_one<5>, dim3(grid), dim3(512), LDS_BYTES, stream, p, l); break;
            default: hipLaunchKernelGGL(mega_one<6>, dim3(grid), dim3(512), LDS_BYTES, stream, p, l); break;
        } }
#else
    p.ph_lo = 0; p.ph_hi = NPH; p.coop = 1;
    if (hipMemsetAsync((char*)d_ws + OFF_BAR, 0, BAR_BYTES, stream) != hipSuccess) { fprintf(stderr, "kernel_launch: hipMemsetAsync of the barrier words failed\n"); return; }
    void* args[] = {&p};
    hipError_t e = hipLaunchCooperativeKernel((const void*)mega_all, dim3(grid), dim3(512), args, LDS_BYTES, stream);
    if (e != hipSuccess) fprintf(stderr, "cooperative launch failed: %s (grid %d)\n", hipGetErrorString(e), grid);
#endif
}
```

```cpp
#include <hip/hip_runtime.h>
#include <hip/hip_cooperative_groups.h>
#include <cstdio>
namespace cg = cooperative_groups;

#ifndef PHMASK
#define PHMASK 127
#endif
#ifndef P2SEL
#define P2SEL 7
#endif
#ifndef MULTI_LAUNCH
#define MULTI_LAUNCH 0
#endif

#define DI __device__ __forceinline__
#define LAS __attribute__((address_space(3)))
typedef unsigned short bf16_t;
typedef short bf16x8 __attribute__((ext_vector_type(8)));
typedef short s16x4 __attribute__((ext_vector_type(4)));
typedef float f32x4 __attribute__((ext_vector_type(4)));
typedef float f32x16 __attribute__((ext_vector_type(16)));
typedef unsigned u32x4 __attribute__((ext_vector_type(4)));
typedef unsigned u32x2 __attribute__((ext_vector_type(2)));
typedef unsigned long long u64;

constexpr int T_ = 16384, S_ = 4096, LDU = 16128;
constexpr int A_Q = 0, A_K = 512, A_V = 1024, A_Z = 1536, A_QI = 2048, A_KI = 2560, A_WI = 2624;
constexpr int B_Q = 2816, B_K = 3328, B_V = 3840, B_Z = 4352, C_F = 4864, C_I = 5376, C_Q = 5888, C_Z = 6400, M_Q = 6912, M_Z = 7424, G_OFF = 7936;
constexpr int IN_W = 15944;
constexpr int NPH = 14;

constexpr size_t OFF_WINT = 0;
constexpr size_t OFF_WBRT = OFF_WINT + (size_t)LDU * 2048 * 2;
constexpr size_t OFF_WOUT = OFF_WBRT + (size_t)2048 * 2048 * 2;
constexpr size_t OFF_WMKV = OFF_WOUT + (size_t)2048 * 2048 * 2;
constexpr size_t OFF_MEMB = OFF_WMKV + (size_t)1024 * 2048 * 2;
constexpr size_t OFF_MKV = OFF_MEMB + (size_t)1024 * 2048 * 2;
constexpr size_t OFF_H = OFF_MKV + (size_t)1024 * 1024 * 2;
constexpr size_t OFF_U = OFF_H + (size_t)T_ * 2048 * 2;
constexpr size_t OFF_Y = OFF_U + (size_t)T_ * LDU * 2;
constexpr size_t OFF_R1 = OFF_Y + (size_t)T_ * 2048 * 2;
constexpr size_t OFF_STB = OFF_R1 + (size_t)T_ * 2048 * 4;
constexpr size_t OFF_STC = OFF_STB + (size_t)1024 * 16384 * 4;
constexpr size_t OFF_DEC = OFF_STC + (size_t)1024 * 16384 * 4;
constexpr size_t OFF_MASK = OFF_DEC + (size_t)1024 * 128 * 4;
constexpr size_t OFF_ROPE = OFF_MASK + (size_t)T_ * 64 * 8;
constexpr size_t WS_END = OFF_ROPE + (size_t)2 * 4096 * 64 * 4;
constexpr size_t OFF_BAR = WS_END;
constexpr size_t BAR_BYTES = 3456 * 4;
constexpr size_t WS_NEED = OFF_BAR + BAR_BYTES;
constexpr int LDS_BYTES = 131072 + 16;

struct Params {
    const float *x, *mem, *norm_g, *w_in, *qk_g, *ret_g, *hgrn_g, *lb_logits, *w_mem_kv, *w_branch, *w_out;
    float* out;
    unsigned char* ws;
    int ph_lo, ph_hi, coop, pad;
};

DI float bf2f(bf16_t b) { return __uint_as_float(((unsigned)b) << 16); }
typedef __bf16 hbf16x2 __attribute__((ext_vector_type(2)));
typedef float f32x2 __attribute__((ext_vector_type(2)));
DI unsigned pk2(float lo, float hi) { const f32x2 v = {lo, hi}; return __builtin_bit_cast(unsigned, __builtin_convertvector(v, hbf16x2)); }
DI bf16_t f2bf(float x) { return (bf16_t)(pk2(x, 0.f) & 0xffffu); }
DI float lo16(unsigned w) { return __uint_as_float(w << 16); }
DI float hi16(unsigned w) { return __uint_as_float(w & 0xffff0000u); }
DI float sigmoidf_(float x) { return 1.0f / (1.0f + __expf(-x)); }
DI float siluf_(float x) { return x / (1.0f + __expf(-x)); }
DI f32x16 zero16() { f32x16 z; for (int i = 0; i < 16; ++i) z[i] = 0.f; return z; }
#define MFMA32(a, b, c) __builtin_amdgcn_mfma_f32_32x32x16_bf16((a), (b), (c), 0, 0, 0)
DI bf16x8 pack8(float a0, float a1, float a2, float a3, float a4, float a5, float a6, float a7) {
    u32x4 w; w.x = pk2(a0, a1); w.y = pk2(a2, a3); w.z = pk2(a4, a5); w.w = pk2(a6, a7);
    return __builtin_bit_cast(bf16x8, w);
}
DI void unpack8(const u32x4 w, float* f) {
    f[0] = lo16(w.x); f[1] = hi16(w.x); f[2] = lo16(w.y); f[3] = hi16(w.y); f[4] = lo16(w.z); f[5] = hi16(w.z); f[6] = lo16(w.w); f[7] = hi16(w.w);
}

namespace pg8 {
constexpr int BM = 256, BK = 64, HALF = 128, HTB = HALF * BK * 2, NXCD = 8, WGM = 8;
DI int lds_byte(int r, int c) { const int st = (r >> 4) * 2 + (c >> 5), rr = r & 15, cc = c & 31, ob = rr * 64 + cc * 2; return st * 1024 + (ob ^ (((ob >> 9) & 1) << 5)); }
DI void stage_rc(int b, int& R, int& C) { const int st = b / 1024, sb = b % 1024, swz = sb ^ (((sb >> 9) & 1) << 5); R = (st >> 1) * 16 + swz / 64; C = (st & 1) * 32 + (swz % 64) / 2; }
DI int perm32(int rho) { const int n = rho >> 4, i = rho & 15; return 8 * (i >> 2) + 4 * n + (i & 3); }
struct Unit { int pm, pn; };
struct Gemm { const bf16_t* A; const bf16_t* Bt; int lda, ldb, M, N, K; };
struct StaticOrder {
    int nM, nN, nwg, G, c;
    DI void init(int M, int N, int G_, int c_) { nM = M / BM; nN = N / BM; nwg = nM * nN; G = G_; c = c_; }
    DI bool next(int i, Unit& u) const {
        const long L = (long)i * G + c; if (L >= nwg) return false;
        int wgid = (int)L; { const int q = nwg / NXCD, r = nwg % NXCD, xcd = wgid % NXCD, off = wgid / NXCD; wgid = (xcd < r ? xcd * (q + 1) : r * (q + 1) + (xcd - r) * q) + off; }
        const int nig = WGM * nN, gid = wgid / nig, fm = gid * WGM, gsz = (nM - fm) < WGM ? (nM - fm) : WGM;
        u.pm = fm + ((wgid % nig) % gsz); u.pn = (wgid % nig) / gsz; return true;
    }
};

struct NoHook { static constexpr bool ON = false; DI void operator()(f32x4 (&)[2][2][4][2], const Unit&, int, int, int, int, int) const {} };
template <class Epi, class Hook = NoHook>
DI void gemm_phase(const int tid, LAS unsigned char* lds, const Gemm g, const StaticOrder& S, const Epi& E, const Hook& HK = Hook()) {
    const int wid = __builtin_amdgcn_readfirstlane(tid >> 6), lane = tid & 63, wr = wid >> 2, wc = wid & 3, fr = lane & 15, fq = lane >> 4;
    const int K = g.K, nt = K / BK;
    unsigned voffA[2], voffB[2];
#pragma unroll
    for (int i = 0; i < 2; ++i) { int R, C; stage_rc(tid * 16 + i * 8192, R, C); const int Rb = Epi::PERM ? ((R & ~31) + perm32(R & 31)) : R;
        voffA[i] = (unsigned)(R * g.lda + C) * 2u; voffB[i] = (unsigned)(Rb * g.ldb + C) * 2u; }
    const size_t kstep = (size_t)(BK * 2);
    const size_t hstepA = (size_t)HALF * g.lda * 2, hstepB = (size_t)HALF * g.ldb * 2;
    const size_t tstepA = 2 * hstepA, tstepB = 2 * hstepB;
    const unsigned ldsw = (unsigned)wid * 1024u;
    const int aoff = lds_byte(wr * 64 + fr, fq * 8), boff = lds_byte(wc * 32 + fr, fq * 8);
#define PG8_SA(b, h) (((b) * 2 + (h)) * HTB)
#define PG8_SB(b, h) ((4 + (b) * 2 + (h)) * HTB)
#define PG8_STAGE(bufoff, gbase, voff) do { _Pragma("unroll") for (int _i = 0; _i < 2; ++_i) \
        __builtin_amdgcn_global_load_lds((const unsigned*)((const char*)(gbase) + (voff)[_i]), (LAS unsigned*)(lds + (bufoff) + ldsw + _i * 8192), 16, 0, 0); } while (0)
#define PG8_LDA(dst, b, h) do { _Pragma("unroll") for (int m = 0; m < 4; ++m) _Pragma("unroll") for (int k = 0; k < 2; ++k) dst[m][k] = *(const LAS bf16x8*)(lds + PG8_SA(b, h) + aoff + m * 2048 + k * 1024); } while (0)
#define PG8_LDB(dst, b, h) do { _Pragma("unroll") for (int n = 0; n < 2; ++n) _Pragma("unroll") for (int k = 0; k < 2; ++k) dst[n][k] = *(const LAS bf16x8*)(lds + PG8_SB(b, h) + boff + n * 2048 + k * 1024); } while (0)
#define PG8_MMA(ai, bj, At, Bt) do { __builtin_amdgcn_s_setprio(1); _Pragma("unroll") for (int m = 0; m < 4; ++m) _Pragma("unroll") for (int n = 0; n < 2; ++n) _Pragma("unroll") for (int k = 0; k < 2; ++k) \
        acc[ai][bj][m][n] = __builtin_amdgcn_mfma_f32_16x16x32_bf16(Bt[n][k], At[m][k], acc[ai][bj][m][n], 0, 0, 0); __builtin_amdgcn_s_setprio(0); } while (0)
#define PG8_WAIT_V(n) asm volatile("s_waitcnt vmcnt(" #n ")" ::: "memory")
#define PG8_WAIT_L(n) asm volatile("s_waitcnt lgkmcnt(" #n ")" ::: "memory")
#define PG8_BAR __builtin_amdgcn_s_barrier()
#define PG8_SCHED __builtin_amdgcn_sched_barrier(0)
    Unit cur, nxt; int ui = 0;
    if (!S.next(0, cur)) return;
    f32x4 acc[2][2][4][2];
#pragma unroll
    for (int a = 0; a < 2; ++a)
#pragma unroll
        for (int b = 0; b < 2; ++b)
#pragma unroll
            for (int m = 0; m < 4; ++m)
#pragma unroll
                for (int n = 0; n < 2; ++n) acc[a][b][m][n] = (f32x4){0.f, 0.f, 0.f, 0.f};
    bf16x8 At[4][2], B0[2][2], B1[2][2];
    const char* cA = (const char*)g.A + (size_t)cur.pm * tstepA; const char* cB = (const char*)g.Bt + (size_t)cur.pn * tstepB;
    PG8_STAGE(PG8_SB(0, 0), cB, voffB); PG8_STAGE(PG8_SA(0, 0), cA, voffA); PG8_STAGE(PG8_SB(0, 1), cB + hstepB, voffB); PG8_STAGE(PG8_SA(0, 1), cA + hstepA, voffA);
    if (wr == 1) PG8_BAR;
    PG8_WAIT_V(4); PG8_BAR;
    PG8_STAGE(PG8_SB(1, 0), cB + kstep, voffB); PG8_STAGE(PG8_SA(1, 0), cA + kstep, voffA); PG8_STAGE(PG8_SB(1, 1), cB + hstepB + kstep, voffB);
    PG8_WAIT_V(6); PG8_BAR;
    for (;;) {
        const bool has_next = S.next(ui + 1, nxt);
        const char* nA = has_next ? (const char*)g.A + (size_t)nxt.pm * tstepA : cA; const char* nB = has_next ? (const char*)g.Bt + (size_t)nxt.pn * tstepB : cB;
        for (int t = 0; t < nt; t += 2) {
            const bool last = (t == nt - 2);
            const char* a1 = cA + (size_t)(t + 1) * kstep;
            const char* a2 = last ? nA : cA + (size_t)(t + 2) * kstep; const char* b2 = last ? nB : cB + (size_t)(t + 2) * kstep;
            const char* a3 = a2 + kstep; const char* b3 = b2 + kstep;
            PG8_LDB(B0, 0, 0); PG8_SCHED; PG8_LDA(At, 0, 0); PG8_STAGE(PG8_SA(1, 1), a1 + hstepA, voffA);
            PG8_WAIT_L(8); PG8_BAR; PG8_WAIT_L(0); PG8_MMA(0, 0, At, B0); PG8_BAR; PG8_SCHED;
            PG8_LDB(B1, 0, 1); PG8_STAGE(PG8_SB(0, 0), b2, voffB);
            PG8_BAR; PG8_WAIT_L(0); PG8_MMA(0, 1, At, B1); PG8_BAR;
            PG8_LDA(At, 0, 1); PG8_STAGE(PG8_SA(0, 0), a2, voffA);
            PG8_BAR; PG8_WAIT_L(0); PG8_MMA(1, 0, At, B0); PG8_BAR; PG8_SCHED;
            PG8_STAGE(PG8_SB(0, 1), b2 + hstepB, voffB);
            PG8_WAIT_V(6); PG8_BAR; PG8_MMA(1, 1, At, B1); PG8_BAR;
            PG8_LDB(B0, 1, 0); PG8_SCHED; PG8_LDA(At, 1, 0); PG8_STAGE(PG8_SA(0, 1), a2 + hstepA, voffA);
            PG8_WAIT_L(8); PG8_BAR; PG8_WAIT_L(0); PG8_MMA(0, 0, At, B0); PG8_BAR; PG8_SCHED;
            PG8_LDB(B1, 1, 1); PG8_STAGE(PG8_SB(1, 0), b3, voffB);
            PG8_BAR; PG8_WAIT_L(0); PG8_MMA(0, 1, At, B1); PG8_BAR;
            PG8_LDA(At, 1, 1); PG8_STAGE(PG8_SA(1, 0), a3, voffA);
            PG8_BAR; PG8_WAIT_L(0); PG8_MMA(1, 0, At, B0); PG8_BAR; PG8_SCHED;
            PG8_STAGE(PG8_SB(1, 1), b3 + hstepB, voffB);
            PG8_WAIT_V(6); PG8_BAR; PG8_MMA(1, 1, At, B1); PG8_BAR;
            if (Hook::ON) { PG8_SCHED; HK(acc, cur, t, wr, wc, fr, fq); PG8_SCHED; }
        }
        E(acc, cur, wr, wc, fr, fq);
        if (!has_next) break;
#pragma unroll
        for (int a = 0; a < 2; ++a)
#pragma unroll
            for (int b = 0; b < 2; ++b)
#pragma unroll
                for (int m = 0; m < 4; ++m)
#pragma unroll
                    for (int n = 0; n < 2; ++n) acc[a][b][m][n] = (f32x4){0.f, 0.f, 0.f, 0.f};
        cur = nxt; cA = nA; cB = nB; ++ui;
    }
    PG8_WAIT_V(0);
    if (wr == 0) PG8_BAR;
    PG8_BAR;
#undef PG8_SA
#undef PG8_SB
#undef PG8_STAGE
#undef PG8_LDA
#undef PG8_LDB
#undef PG8_MMA
#undef PG8_WAIT_V
#undef PG8_WAIT_L
#undef PG8_BAR
#undef PG8_SCHED
}

struct EpiBf16 {
    static constexpr bool PERM = true;
    bf16_t* O; int ldc; int sig_pn;
    DI void operator()(const f32x4 (&acc)[2][2][4][2], const Unit& u, int wr, int wc, int fr, int fq) const {
        const int row0 = u.pm * BM + wr * 64 + fr, col0 = u.pn * BM + wc * 32 + 8 * fq;
        const bool sg = u.pn >= sig_pn;
#pragma unroll
        for (int ai = 0; ai < 2; ++ai)
#pragma unroll
            for (int m = 0; m < 4; ++m) { bf16_t* rowp = O + (size_t)(row0 + ai * HALF + m * 16) * ldc + col0;
#pragma unroll
                for (int bj = 0; bj < 2; ++bj) { f32x4 v0 = acc[ai][bj][m][0], v1 = acc[ai][bj][m][1];
                    if (sg) {
#pragma unroll
                        for (int j = 0; j < 4; ++j) { v0[j] = sigmoidf_(v0[j]); v1[j] = sigmoidf_(v1[j]); } }
                    u32x4 w; w.x = pk2(v0[0], v0[1]); w.y = pk2(v0[2], v0[3]); w.z = pk2(v1[0], v1[1]); w.w = pk2(v1[2], v1[3]);
                    *(u32x4*)(rowp + bj * HALF) = w; }
                __builtin_amdgcn_sched_barrier(0); }
    }
};
struct EpiGateRatio {
    static constexpr bool PERM = false;
    bf16_t* U;
    DI void operator()(const f32x4 (&acc)[2][2][4][2], const Unit& u, int wr, int wc, int fr, int fq) const {
        const int row0 = u.pm * BM + wr * 64 + fr, c0 = u.pn * 64 + 16 * wc + 4 * fq;
#pragma unroll
        for (int ai = 0; ai < 2; ++ai)
#pragma unroll
            for (int m = 0; m < 4; ++m) { bf16_t* rowp = U + (size_t)(row0 + ai * HALF + m * 16) * LDU + G_OFF + c0;
                float r0[4], r1[4], r2[4], g3[4];
#pragma unroll
                for (int j = 0; j < 4; ++j) { const float e0 = __expf(-acc[ai][0][m][0][j]), e1 = __expf(-acc[ai][0][m][1][j]), e2 = __expf(-acc[ai][1][m][0][j]), e3 = __expf(-acc[ai][1][m][1][j]);
                    const float i0 = __builtin_amdgcn_rcpf(1.0f + e0), i1 = __builtin_amdgcn_rcpf(1.0f + e1), i2 = __builtin_amdgcn_rcpf(1.0f + e2), i3 = __builtin_amdgcn_rcpf(1.0f + e3);
                    r0[j] = (1.0f + e1) * i0; r1[j] = (1.0f + e2) * i1; r2[j] = (1.0f + e3) * i2; g3[j] = i3; }
                u32x2 w;
                w.x = pk2(r0[0], r0[1]); w.y = pk2(r0[2], r0[3]); *(u32x2*)(rowp) = w;
                w.x = pk2(r1[0], r1[1]); w.y = pk2(r1[2], r1[3]); *(u32x2*)(rowp + 2048) = w;
                w.x = pk2(r2[0], r2[1]); w.y = pk2(r2[2], r2[3]); *(u32x2*)(rowp + 4096) = w;
                w.x = pk2(g3[0], g3[1]); w.y = pk2(g3[2], g3[3]); *(u32x2*)(rowp + 6144) = w;
                __builtin_amdgcn_sched_barrier(0); }
    }
};
struct HookGate {
    static constexpr bool ON = true;
    const bf16_t* U;
    DI void operator()(f32x4 (&acc)[2][2][4][2], const Unit& u, int t, int wr, int wc, int fr, int fq) const {
        if ((t & 7) != 6 || t >= 24) return;
        const int seg = t >> 3;
        int row0 = u.pm * BM + wr * 64 + fr, col0 = u.pn * BM + wc * 32 + 8 * fq;
        asm volatile("" : "+v"(row0), "+v"(col0));
#pragma unroll
        for (int ai = 0; ai < 2; ++ai) {
            u32x4 ga[4][2];
#pragma unroll
            for (int m = 0; m < 4; ++m) { const bf16_t* gp = U + (size_t)(row0 + ai * HALF + m * 16) * LDU + G_OFF + seg * 2048 + col0;
#pragma unroll
                for (int bj = 0; bj < 2; ++bj) ga[m][bj] = *(const u32x4*)(gp + bj * HALF); }
#pragma unroll
            for (int m = 0; m < 4; ++m)
#pragma unroll
                for (int bj = 0; bj < 2; ++bj) { const u32x4 a = ga[m][bj];
                    f32x4& v0 = acc[ai][bj][m][0]; f32x4& v1 = acc[ai][bj][m][1];
                    v0[0] *= lo16(a.x); v0[1] *= hi16(a.x); v0[2] *= lo16(a.y); v0[3] *= hi16(a.y);
                    v1[0] *= lo16(a.z); v1[1] *= hi16(a.z); v1[2] *= lo16(a.w); v1[3] *= hi16(a.w); }
            __builtin_amdgcn_sched_barrier(0); }
    }
};
struct EpiMerged {
    static constexpr bool PERM = true;
    bf16_t* Mb; const bf16_t* U;
    DI void operator()(const f32x4 (&acc)[2][2][4][2], const Unit& u, int wr, int wc, int fr, int fq) const {
        const int row0 = u.pm * BM + wr * 64 + fr, col0 = u.pn * BM + wc * 32 + 8 * fq;
#pragma unroll
        for (int ai = 0; ai < 2; ++ai) {
            u32x4 gw[4][2];
#pragma unroll
            for (int m = 0; m < 4; ++m) { const size_t row = (size_t)(row0 + ai * HALF + m * 16);
#pragma unroll
                for (int bj = 0; bj < 2; ++bj) gw[m][bj] = *(const u32x4*)(U + row * LDU + G_OFF + 3 * 2048 + col0 + bj * HALF); }
#pragma unroll
            for (int m = 0; m < 4; ++m) { const size_t row = (size_t)(row0 + ai * HALF + m * 16);
#pragma unroll
                for (int bj = 0; bj < 2; ++bj) { const u32x4 g = gw[m][bj]; const f32x4 v0 = acc[ai][bj][m][0], v1 = acc[ai][bj][m][1];
                    u32x4 w; w.x = pk2(v0[0] * lo16(g.x), v0[1] * hi16(g.x)); w.y = pk2(v0[2] * lo16(g.y), v0[3] * hi16(g.y));
                    w.z = pk2(v1[0] * lo16(g.z), v1[1] * hi16(g.z)); w.w = pk2(v1[2] * lo16(g.w), v1[3] * hi16(g.w));
                    *(u32x4*)(Mb + row * 2048 + col0 + bj * HALF) = w; } }
            __builtin_amdgcn_sched_barrier(0); }
    }
};
struct EpiOut {
    static constexpr bool PERM = false;
    const float* xin; float* out;
    DI void operator()(const f32x4 (&acc)[2][2][4][2], const Unit& u, int wr, int wc, int fr, int fq) const {
        const int row0 = u.pm * BM + wr * 64 + fr, col0 = u.pn * BM + wc * 32 + 4 * fq;
#pragma unroll
        for (int ai = 0; ai < 2; ++ai) {
            f32x4 xv[4][4];
#pragma unroll
            for (int m = 0; m < 4; ++m) { const size_t row = (size_t)(row0 + ai * HALF + m * 16);
#pragma unroll
                for (int bj = 0; bj < 2; ++bj)
#pragma unroll
                    for (int n = 0; n < 2; ++n) xv[m][bj * 2 + n] = *(const f32x4*)(xin + row * 2048 + col0 + bj * HALF + n * 16); }
#pragma unroll
            for (int m = 0; m < 4; ++m) { const size_t row = (size_t)(row0 + ai * HALF + m * 16);
#pragma unroll
                for (int bj = 0; bj < 2; ++bj)
#pragma unroll
                    for (int n = 0; n < 2; ++n) *(f32x4*)(out + row * 2048 + col0 + bj * HALF + n * 16) = xv[m][bj * 2 + n] + acc[ai][bj][m][n]; }
            __builtin_amdgcn_sched_barrier(0); }
    }
};
}

DI void tr_tile(const int tid, bf16_t* sT, const float* __restrict__ src, int ld_src, int k0, int n0, bf16_t* __restrict__ dst, int ld_dst, int koff, bool winmap) {
    const int n4 = (tid & 31) * 4, kb = tid >> 5;
    const int n = n0 + n4; int sc = n;
    if (winmap) {
        if (n < G_OFF) sc = (n < 2632) ? n : (n < 2816 ? -1 : n - 184);
        else {
            const int t = n - G_OFF, tc = t & 255, bj = tc >> 7, wc = (tc >> 5) & 3, n1 = (tc >> 4) & 1, fq = (tc >> 2) & 3;
            sc = (G_OFF - 184) + (2 * bj + n1) * 2048 + 64 * (t >> 8) + 16 * wc + 4 * fq; }
    }
    f32x4 v[4];
#pragma unroll
    for (int i = 0; i < 4; ++i) v[i] = (sc >= 0) ? *(const f32x4*)(src + (size_t)(k0 + i * 16 + kb) * ld_src + sc) : (f32x4){0.f, 0.f, 0.f, 0.f};
#pragma unroll
    for (int i = 0; i < 4; ++i)
#pragma unroll
        for (int e = 0; e < 4; ++e) sT[(n4 + e) * 66 + i * 16 + kb] = f2bf(v[i][e]);
    __syncthreads();
#pragma unroll
    for (int h = 0; h < 2; ++h) { const int n2 = (tid >> 3) + h * 64, kc = (tid & 7) * 8; const unsigned* sp = (const unsigned*)(sT + n2 * 66 + kc);
        u32x4 w; w.x = sp[0]; w.y = sp[1]; w.z = sp[2]; w.w = sp[3];
        *(u32x4*)(dst + (size_t)(n0 + n2) * ld_dst + koff + k0 + kc) = w; }
    __syncthreads();
}

DI void phase_prep(const int tid, const int bid, unsigned char* smem, const Params& p, int l) {
    bf16_t* sT = (bf16_t*)smem;
    const int G = gridDim.x, wid = tid >> 6, lane = tid & 63;
    bf16_t* WinT = (bf16_t*)(p.ws + OFF_WINT); bf16_t* WbrT = (bf16_t*)(p.ws + OFF_WBRT); bf16_t* WoutT = (bf16_t*)(p.ws + OFF_WOUT); bf16_t* WmkvT = (bf16_t*)(p.ws + OFF_WMKV);
    for (int t = bid; t < 4032 + 512 + 512 + 256; t += G) {
        if (t < 4032) { const int kt = t & 31, ntl = t >> 5; tr_tile(tid, sT, p.w_in + (size_t)l * 2048 * IN_W, IN_W, kt * 64, ntl * 128, WinT, 2048, 0, true); }
        else if (t < 4544) { const int u = t - 4032, nb = u >> 7, rem = u & 127, kt = rem & 7, ct = rem >> 3;
            tr_tile(tid, sT, p.w_branch + ((size_t)(l * 4 + nb) * 512) * 2048, 2048, kt * 64, ct * 128, WbrT, 2048, nb * 512, false); }
        else if (t < 5056) { const int u = t - 4544, kt = u & 31, ntl = u >> 5; tr_tile(tid, sT, p.w_out + (size_t)l * 2048 * 2048, 2048, kt * 64, ntl * 128, WoutT, 2048, 0, false); }
        else { const int u = t - 5056, kt = u & 31, ntl = u >> 5; tr_tile(tid, sT, p.w_mem_kv + (size_t)l * 2048 * 1024, 1024, kt * 64, ntl * 128, WmkvT, 2048, 0, false); }
    }
    const float* xin = l == 0 ? p.x : p.out; const float* g = p.norm_g + l * 2048; bf16_t* H = (bf16_t*)(p.ws + OFF_H);
    for (int row = bid * 8 + wid; row < T_; row += G * 8) {
        const float* xr = xin + (size_t)row * 2048; f32x4 v[8]; float ss = 0.f;
#pragma unroll
        for (int i = 0; i < 8; ++i) { v[i] = *(const f32x4*)(xr + i * 256 + lane * 4); ss += v[i][0] * v[i][0] + v[i][1] * v[i][1] + v[i][2] * v[i][2] + v[i][3] * v[i][3]; }
#pragma unroll
        for (int m = 32; m >= 1; m >>= 1) ss += __shfl_xor(ss, m);
        const float rs = rsqrtf(ss * (1.f / 2048.f) + 1e-6f);
#pragma unroll
        for (int i = 0; i < 8; ++i) { const f32x4 gg = *(const f32x4*)(g + i * 256 + lane * 4); u32x2 w; w.x = pk2(v[i][0] * rs * gg[0], v[i][1] * rs * gg[1]); w.y = pk2(v[i][2] * rs * gg[2], v[i][3] * rs * gg[3]);
            *(u32x2*)(H + (size_t)row * 2048 + i * 256 + lane * 4) = w; }
    }
    if (l == 0) {
        bf16_t* memb = (bf16_t*)(p.ws + OFF_MEMB);
        for (int i = bid * 512 + tid; i < 1024 * 2048 / 4; i += G * 512) { const f32x4 v = *(const f32x4*)(p.mem + (size_t)i * 4); u32x2 w; w.x = pk2(v[0], v[1]); w.y = pk2(v[2], v[3]); *(u32x2*)(memb + (size_t)i * 4) = w; }
        float* rope = (float*)(p.ws + OFF_ROPE);
        for (int i = bid * 512 + tid; i < 4096 * 64; i += G * 512) { const int pos = i >> 6, fi = i & 63;
            const float inv = __builtin_amdgcn_exp2f(-(float)fi * (13.287712379549449f / 64.f));
            const float ang = (float)pos * inv;
            const double rev = (double)ang * 0.15915494309189535; const float fr = (float)(rev - floor(rev));
            rope[i] = __builtin_amdgcn_cosf(fr); rope[4096 * 64 + i] = __builtin_amdgcn_sinf(fr); }
    }
}

template <int K>
DI u64 select_row(const float* __restrict__ rowp, const int nvalid  , unsigned* sS, const int lane) {
    unsigned key[K];
    const bool act = lane * K < nvalid;
    const float* sp = rowp + (act ? lane : 0) * K;
#pragma unroll
    for (int j4 = 0; j4 < K / 4; ++j4) { const f32x4 v4 = *(const f32x4*)(sp + 4 * j4);
#pragma unroll
        for (int e = 0; e < 4; ++e) { const float v = v4[e] + 0.0f; const unsigned u = __float_as_uint(v); const unsigned k = (u & 0x80000000u) ? ~u : (u | 0x80000000u); key[4 * j4 + e] = act ? k : 0u; } }
#define COUNT_GE(cand_, out_) do { int cs_ = 0, cv_ = 0; \
        _Pragma("unroll") for (int j = 0; j < K; j += 8) { \
            const u64 m0_ = __ballot(key[j] >= (cand_)), m1_ = __ballot(key[j + 1] >= (cand_)), m2_ = __ballot(key[j + 2] >= (cand_)), m3_ = __ballot(key[j + 3] >= (cand_)), m4_ = __ballot(key[j + 4] >= (cand_)), m5_ = __ballot(key[j + 5] >= (cand_)); \
            cv_ += (key[j + 6] >= (cand_)) ? 1 : 0; cv_ += (key[j + 7] >= (cand_)) ? 1 : 0; \
            __builtin_amdgcn_sched_barrier(0); \
            cs_ += __popcll(m0_) + __popcll(m1_) + __popcll(m2_) + __popcll(m3_) + __popcll(m4_) + __popcll(m5_); \
            __builtin_amdgcn_sched_barrier(0); } \
        cv_ += __builtin_amdgcn_update_dpp(0, cv_, 0xB1, 0xf, 0xf, false); cv_ += __builtin_amdgcn_update_dpp(0, cv_, 0x4E, 0xf, 0xf, false); \
        cv_ += __builtin_amdgcn_update_dpp(0, cv_, 0x141, 0xf, 0xf, false); cv_ += __builtin_amdgcn_update_dpp(0, cv_, 0x140, 0xf, 0xf, false); \
        out_ = cs_ + __builtin_amdgcn_readlane(cv_, 0) + __builtin_amdgcn_readlane(cv_, 16) + __builtin_amdgcn_readlane(cv_, 32) + __builtin_amdgcn_readlane(cv_, 48); } while (0)
    unsigned Tk = 0u; int cge = 64 * K, cab = 0;
    for (int bit = 31; bit >= 16; --bit) { const unsigned cand = Tk | (1u << bit); int cnt; COUNT_GE(cand, cnt); if (cnt >= 256) { Tk = cand; cge = cnt; } else cab = cnt; }
    const int nsurv = cge - cab, needb = 256 - cab;
    int tot_ge;
    if (nsurv <= 64) {
        int ns = 0;
#pragma unroll
        for (int j = 0; j < K; ++j) ns += ((key[j] >> 16) == (Tk >> 16)) ? 1 : 0;
        int pre = ns;
#pragma unroll
        for (int m = 1; m < 64; m <<= 1) { const int o = __shfl_up(pre, m); if (lane >= m) pre += o; }
        int pos = pre - ns;
#pragma unroll
        for (int j = 0; j < K; ++j) { const bool is = (key[j] >> 16) == (Tk >> 16); sS[is ? pos : 64 + lane] = key[j]; pos += is ? 1 : 0; }
        const unsigned sk = (lane < nsurv) ? sS[lane] : 0u;
        int cgb = nsurv;
        for (int bit = 15; bit >= 0; --bit) { const unsigned cand = Tk | (1u << bit); const int cnt = __popcll(__ballot(sk >= cand)); if (cnt >= needb) { Tk = cand; cgb = cnt; } }
        tot_ge = cab + cgb;
    } else {
        for (int bit = 15; bit >= 0; --bit) { const unsigned cand = Tk | (1u << bit); int cnt; COUNT_GE(cand, cnt); if (cnt >= 256) { Tk = cand; cge = cnt; } }
        tot_ge = cge;
    }
#undef COUNT_GE
    u64 bits = 0ull;
    if (tot_ge == 256) {
        unsigned lo = 0u, hi = 0u;
#pragma unroll
        for (int j = 0; j < 32; ++j) { lo |= (key[j] >= Tk) ? (1u << j) : 0u; if (K == 64) hi |= (key[(K == 64 ? 32 : 0) + j] >= Tk) ? (1u << j) : 0u; }
        bits = (u64)lo | ((u64)hi << 32);
    } else {
        int tg = 0, ceq = 0;
#pragma unroll
        for (int j = 0; j < K; ++j) { tg += __popcll(__ballot(key[j] > Tk)); ceq += (key[j] == Tk) ? 1 : 0; if ((j & 3) == 3) __builtin_amdgcn_sched_barrier(0); }
        const int need = 256 - tg;
#pragma unroll
        for (int j = 0; j < K; ++j) asm volatile("" : "+v"(key[j]));
        int pre = ceq;
#pragma unroll
        for (int m = 1; m < 64; m <<= 1) { const int o = __shfl_up(pre, m); if (lane >= m) pre += o; }
        int run = pre - ceq;
#pragma unroll
        for (int j = 0; j < K; ++j) { const bool eq = key[j] == Tk; const bool sel = (key[j] > Tk) || (eq && run < need); run += eq ? 1 : 0; bits |= sel ? (1ull << j) : 0ull; if ((j & 3) == 3) __builtin_amdgcn_sched_barrier(0); }
    }
    return bits;
}

DI void index_item(const int tid, const int bid, unsigned char* smem, const Params& p, int b, int c, int qhalf) {
    bf16_t* sQi = (bf16_t*)smem;
    const bf16_t* U = (const bf16_t*)(p.ws + OFF_U);
    float* scr = (float*)(p.ws + OFF_R1) + (size_t)bid * (32 * 4096);
    u64* mask = (u64*)(p.ws + OFF_MASK);
    const int wid = tid >> 6, lane = tid & 63, l31 = lane & 31, hh = lane >> 5;
    const int ntile = c + 1, q0 = c * 64 + qhalf * 32; const size_t rowb = (size_t)b * S_;
    __syncthreads();
#pragma unroll
    for (int i = 0; i < 4; ++i) { const int ch = tid + i * 512, r = ch >> 6, cc = (ch & 63) * 8;
        *(u32x4*)(sQi + r * 520 + cc) = *(const u32x4*)(U + (rowb + q0 + r) * LDU + A_QI + cc); }
    float* sW = (float*)(smem + 33280);
    if (tid < 256) { const int r = tid >> 3, hd = tid & 7; sW[tid] = bf2f(U[(rowb + q0 + r) * LDU + A_WI + hd]) * (0.125f * 0.35355339059327373f); }
    __syncthreads();
    bf16x8 kfn[2][4];
    if (wid < ntile) {
#pragma unroll
        for (int mt = 0; mt < 2; ++mt)
#pragma unroll
            for (int s = 0; s < 4; ++s) kfn[mt][s] = *(const bf16x8*)(U + (rowb + wid * 64 + 32 * mt + l31) * LDU + A_KI + 16 * s + 8 * hh);
    }
    for (int kt = wid; kt < ntile; kt += 8) {
        bf16x8 kf[2][4];
#pragma unroll
        for (int mt = 0; mt < 2; ++mt)
#pragma unroll
            for (int s = 0; s < 4; ++s) kf[mt][s] = kfn[mt][s];
        if (kt + 8 < ntile) {
#pragma unroll
            for (int mt = 0; mt < 2; ++mt)
#pragma unroll
                for (int s = 0; s < 4; ++s) kfn[mt][s] = *(const bf16x8*)(U + (rowb + (kt + 8) * 64 + 32 * mt + l31) * LDU + A_KI + 16 * s + 8 * hh);
        }
        f32x16 sc[2]; sc[0] = zero16(); sc[1] = zero16();
#pragma unroll 1
        for (int hd = 0; hd < 8; ++hd) {
            bf16x8 qv[4];
#pragma unroll
            for (int s = 0; s < 4; ++s) qv[s] = *(const bf16x8*)(sQi + l31 * 520 + hd * 64 + 16 * s + 8 * hh);
            const float wv = sW[l31 * 8 + hd];
#pragma unroll
            for (int mt = 0; mt < 2; ++mt) { f32x16 rel = zero16();
#pragma unroll
                for (int s = 0; s < 4; ++s) rel = MFMA32(kf[mt][s], qv[s], rel);
#pragma unroll
                for (int r = 0; r < 16; ++r) sc[mt][r] += fmaxf(rel[r], 0.f) * wv; }
        }
#pragma unroll
        for (int mt = 0; mt < 2; ++mt)
#pragma unroll
            for (int rg = 0; rg < 4; ++rg) { f32x4 v; v[0] = sc[mt][4 * rg]; v[1] = sc[mt][4 * rg + 1]; v[2] = sc[mt][4 * rg + 2]; v[3] = sc[mt][4 * rg + 3];
                *(f32x4*)(scr + (size_t)l31 * 4096 + kt * 64 + 32 * mt + 8 * rg + 4 * hh) = v; }
    }
    __syncthreads();
    for (int qi = 0; qi < 4; ++qi) {
        const int qq = wid * 4 + qi; u64 myword = 0ull;
        unsigned* sS = (unsigned*)(smem + 36864) + wid * 128;
        if (ntile <= 4) { myword = (lane < ntile) ? ~0ull : 0ull; }
        else if (ntile <= 32) {
            const unsigned b32 = (unsigned)select_row<32>(scr + (size_t)qq * 4096, ntile * 64, sS, lane);
            const unsigned lo = (unsigned)__shfl((int)b32, (2 * lane) & 63), hi = (unsigned)__shfl((int)b32, (2 * lane + 1) & 63);
            myword = lane < 32 ? ((u64)lo | ((u64)hi << 32)) : 0ull;
        } else myword = select_row<64>(scr + (size_t)qq * 4096, ntile * 64, sS, lane);
        mask[(rowb + q0 + qq) * 64 + lane] = myword;
    }
}

DI void norm_region(bf16_t* ptr, const float* g, int lane) {
    const u32x4 w = *(const u32x4*)(ptr + lane * 8); float f[8]; unpack8(w, f); float ss = 0.f;
#pragma unroll
    for (int j = 0; j < 8; ++j) ss += f[j] * f[j];
    ss += __shfl_xor(ss, 1); ss += __shfl_xor(ss, 2); ss += __shfl_xor(ss, 4); ss += __shfl_xor(ss, 8);
    const float rs = rsqrtf(ss * (1.f / 128.f) + 1e-6f);
    const f32x4 g0 = *(const f32x4*)(g + (lane & 15) * 8), g1 = *(const f32x4*)(g + (lane & 15) * 8 + 4);
    *(bf16x8*)(ptr + lane * 8) = pack8(f[0] * rs * g0[0], f[1] * rs * g0[1], f[2] * rs * g0[2], f[3] * rs * g0[3], f[4] * rs * g1[0], f[5] * rs * g1[1], f[6] * rs * g1[2], f[7] * rs * g1[3]);
}
DI void qknorm_pass(const int tid, const int bid, const Params& p, int l) {
    const int wid = tid >> 6, lane = tid & 63, G = gridDim.x;
    bf16_t* U = (bf16_t*)(p.ws + OFF_U); bf16_t* MKV = (bf16_t*)(p.ws + OFF_MKV);
    const float* g = p.qk_g + l * 512;
    for (int row = bid * 8 + wid; row < T_ + 1024; row += G * 8) {
        if (row < T_) { bf16_t* ur = U + (size_t)row * LDU; norm_region(ur + A_Q, g, lane); norm_region(ur + A_K, g + 128, lane); norm_region(ur + M_Q, g + 256, lane); }
        else norm_region(MKV + (size_t)(row - T_) * 1024, g + 384, lane);
    }
}

constexpr int AT_SK = 0, AT_SV = 17408, AT_BUF = 18944;
template <int MODE>
DI void attn_range(const int tid, unsigned char* smem, const Params& p, int b, int hd, int q0, int kt0, int kt1, f32x16 (&ot)[4], float& lsum) {
    bf16_t* sK = (bf16_t*)(smem + AT_SK); bf16_t* sV = (bf16_t*)(smem + AT_SV);
    const bf16_t* U = (const bf16_t*)(p.ws + OFF_U); const bf16_t* MKV = (const bf16_t*)(p.ws + OFF_MKV);
    const u64* mask = (const u64*)(p.ws + OFF_MASK);
    const int wid = tid >> 6, lane = tid & 63, l31 = lane & 31, hh = lane >> 5;
    const size_t row = (size_t)b * S_ + q0 + wid * 32 + l31;
    bf16x8 qf[8];
    { const bf16_t* qp = U + row * LDU + (MODE == 0 ? M_Q : A_Q) + hd * 128 + 8 * hh;
#pragma unroll
      for (int s = 0; s < 8; ++s) qf[s] = *(const bf16x8*)(qp + 16 * s); }
    ot[0] = zero16(); ot[1] = zero16(); ot[2] = zero16(); ot[3] = zero16(); lsum = 0.f;
    const int skey = tid >> 4, spart = tid & 15;
    const bf16_t* kbase = MODE == 0 ? MKV + (size_t)(b * 256 + skey) * 1024 + hd * 128 + spart * 8 : U + ((size_t)b * S_ + skey) * LDU + A_K + hd * 128 + spart * 8;
    const size_t ldk = MODE == 0 ? 1024 : LDU, voff = MODE == 0 ? 512 : (A_V - A_K);
    u32x4 kr[2], vr[2]; u64 mwc = 0ull, mwn = 0ull;
    const int i16 = lane & 15, tq = i16 >> 2, tp = i16 & 3, tgrp = l31 >> 4;
    __syncthreads();
    { const bf16_t* kp = kbase + (size_t)kt0 * 64 * ldk;
      kr[0] = *(const u32x4*)kp; kr[1] = *(const u32x4*)(kp + 32 * ldk); vr[0] = *(const u32x4*)(kp + voff); vr[1] = *(const u32x4*)(kp + 32 * ldk + voff);
      if (MODE == 1) mwc = mask[row * 64 + kt0];
      *(u32x4*)(sK + skey * 136 + spart * 8) = kr[0]; *(u32x4*)(sK + (skey + 32) * 136 + spart * 8) = kr[1];
      *(u32x4*)(sV + skey * 160 + spart * 8) = vr[0]; *(u32x4*)(sV + (skey + 32) * 160 + spart * 8) = vr[1]; }
    if (kt0 + 1 < kt1) { const bf16_t* kp = kbase + (size_t)(kt0 + 1) * 64 * ldk;
        kr[0] = *(const u32x4*)kp; kr[1] = *(const u32x4*)(kp + 32 * ldk); vr[0] = *(const u32x4*)(kp + voff); vr[1] = *(const u32x4*)(kp + 32 * ldk + voff);
        if (MODE == 1) mwn = mask[row * 64 + kt0 + 1]; }
    __syncthreads();
    int cur = 0;
    for (int kt = kt0; kt < kt1; ++kt) {
        const bf16_t* sKc = sK + cur * AT_BUF; const bf16_t* sVc = sV + cur * AT_BUF;
        const u64 mwh = mwc >> (4 * hh);
        if (kt + 1 < kt1) { bf16_t* sKn = sK + (cur ^ 1) * AT_BUF; bf16_t* sVn = sV + (cur ^ 1) * AT_BUF;
            *(u32x4*)(sKn + skey * 136 + spart * 8) = kr[0]; *(u32x4*)(sKn + (skey + 32) * 136 + spart * 8) = kr[1];
            *(u32x4*)(sVn + skey * 160 + spart * 8) = vr[0]; *(u32x4*)(sVn + (skey + 32) * 160 + spart * 8) = vr[1];
            mwc = mwn; }
        if (kt + 2 < kt1) { const bf16_t* kp = kbase + (size_t)(kt + 2) * 64 * ldk;
            kr[0] = *(const u32x4*)kp; kr[1] = *(const u32x4*)(kp + 32 * ldk); vr[0] = *(const u32x4*)(kp + voff); vr[1] = *(const u32x4*)(kp + 32 * ldk + voff);
            if (MODE == 1) mwn = mask[row * 64 + kt + 2]; }
        f32x16 st[2]; st[0] = zero16(); st[1] = zero16();
#pragma unroll
        for (int mt = 0; mt < 2; ++mt)
#pragma unroll
            for (int s = 0; s < 8; ++s) { const bf16x8 kf = *(const bf16x8*)(sKc + (32 * mt + l31) * 136 + 16 * s + 8 * hh); st[mt] = MFMA32(kf, qf[s], st[mt]); }
        bf16x8 pb[2][2];
#pragma unroll
        for (int mt = 0; mt < 2; ++mt) {
            const int mw32 = (int)(unsigned)(mwh >> (32 * mt));
#pragma unroll
            for (int r = 0; r < 16; ++r) { float pv = __builtin_amdgcn_exp2f(st[mt][r] * (0.08838834764831845f * 1.4426950408889634f));
                if (MODE == 1) pv = __int_as_float(__float_as_int(pv) & __builtin_amdgcn_sbfe(mw32, (r & 3) + 8 * (r >> 2), 1));
                lsum += pv; st[mt][r] = pv; }
            pb[mt][0] = pack8(st[mt][0], st[mt][1], st[mt][2], st[mt][3], st[mt][4], st[mt][5], st[mt][6], st[mt][7]);
            pb[mt][1] = pack8(st[mt][8], st[mt][9], st[mt][10], st[mt][11], st[mt][12], st[mt][13], st[mt][14], st[mt][15]);
        }
#pragma unroll
        for (int i = 0; i < 4; ++i)
#pragma unroll
            for (int mt = 0; mt < 2; ++mt)
#pragma unroll
                for (int s2 = 0; s2 < 2; ++s2) { const bf16_t* vp = sVc + (32 * mt + 16 * s2 + 4 * hh + tq) * 160 + 32 * i + 16 * tgrp + 4 * tp;
                    const s16x4 lo = __builtin_amdgcn_ds_read_tr16_b64_v4i16((LAS s16x4*)vp), hi = __builtin_amdgcn_ds_read_tr16_b64_v4i16((LAS s16x4*)(vp + 8 * 160));
                    ot[i] = MFMA32(__builtin_shufflevector(lo, hi, 0, 1, 2, 3, 4, 5, 6, 7), pb[mt][s2], ot[i]); }
        __syncthreads();
        cur ^= 1;
    }
    lsum += __shfl_xor(lsum, 32);
}

DI void attnM_item(const int tid, unsigned char* smem, const Params& p, int item) {
    const bf16_t* U = (const bf16_t*)(p.ws + OFF_U); bf16_t* Y = (bf16_t*)(p.ws + OFF_Y);
    const int wid = tid >> 6, lane = tid & 63, l31 = lane & 31, hh = lane >> 5;
    const int b = item >> 6, qt = (item >> 2) & 15, hd = item & 3, q0 = qt * 256;
    f32x16 ot[4]; float lsum;
    attn_range<0>(tid, smem, p, b, hd, q0, 0, 4, ot, lsum);
    const size_t row = (size_t)b * S_ + q0 + wid * 32 + l31; const float inv = 1.0f / lsum;
#pragma unroll
    for (int i = 0; i < 4; ++i)
#pragma unroll
        for (int rg = 0; rg < 4; ++rg) { const int col = hd * 128 + 32 * i + 8 * rg + 4 * hh;
            const u32x2 zw = *(const u32x2*)(U + row * LDU + M_Z + col);
            u32x2 w; w.x = pk2(ot[i][4 * rg] * inv * siluf_(lo16(zw.x)), ot[i][4 * rg + 1] * inv * siluf_(hi16(zw.x)));
            w.y = pk2(ot[i][4 * rg + 2] * inv * siluf_(lo16(zw.y)), ot[i][4 * rg + 3] * inv * siluf_(hi16(zw.y)));
            *(u32x2*)(Y + row * 2048 + 3 * 512 + col) = w; }
}
DI void attnA_item(const int tid, unsigned char* smem, const Params& p, int item) {
    float* Opart = (float*)(p.ws + OFF_R1); float* lpart = Opart + (size_t)2 * T_ * 512;
    const int wid = tid >> 6, lane = tid & 63, l31 = lane & 31, hh = lane >> 5;
    const int b = item >> 6, hd = (item >> 4) & 3, pr = (item >> 1) & 7, half = item & 1;
#pragma unroll 1
    for (int sub = 0; sub < 2; ++sub) {
        const int qt = sub == 0 ? pr : 15 - pr, n2 = 2 * (qt + 1), q0 = qt * 256;
        f32x16 ot[4]; float lsum;
        attn_range<1>(tid, smem, p, b, hd, q0, half * n2, (half + 1) * n2, ot, lsum);
        const size_t row = (size_t)b * S_ + q0 + wid * 32 + l31;
        float* op = Opart + ((size_t)half * T_ + row) * 512 + hd * 128;
#pragma unroll
        for (int i = 0; i < 4; ++i)
#pragma unroll
            for (int rg = 0; rg < 4; ++rg) { f32x4 v; v[0] = ot[i][4 * rg]; v[1] = ot[i][4 * rg + 1]; v[2] = ot[i][4 * rg + 2]; v[3] = ot[i][4 * rg + 3];
                *(f32x4*)(op + 32 * i + 8 * rg + 4 * hh) = v; }
        if (hh == 0) lpart[((size_t)half * T_ + row) * 4 + hd] = lsum;
    }
}
DI void attnA_finalize(const int tid, const int bid, const Params& p) {
    const float* Opart = (const float*)(p.ws + OFF_R1); const float* lpart = Opart + (size_t)2 * T_ * 512;
    const bf16_t* U = (const bf16_t*)(p.ws + OFF_U); bf16_t* Y = (bf16_t*)(p.ws + OFF_Y);
    for (int i = bid * 512 + tid; i < T_ * 128; i += gridDim.x * 512) { const int row = i >> 7, c4 = (i & 127) * 4, hd = c4 >> 7;
        const f32x4 o0 = *(const f32x4*)(Opart + (size_t)row * 512 + c4), o1 = *(const f32x4*)(Opart + ((size_t)T_ + row) * 512 + c4);
        const float inv = 1.0f / (lpart[(size_t)row * 4 + hd] + lpart[((size_t)T_ + row) * 4 + hd]);
        const u32x2 zw = *(const u32x2*)(U + (size_t)row * LDU + A_Z + c4);
        u32x2 w; w.x = pk2((o0[0] + o1[0]) * inv * siluf_(lo16(zw.x)), (o0[1] + o1[1]) * inv * siluf_(hi16(zw.x)));
        w.y = pk2((o0[2] + o1[2]) * inv * siluf_(lo16(zw.y)), (o0[3] + o1[3]) * inv * siluf_(hi16(zw.y)));
        *(u32x2*)(Y + (size_t)row * 2048 + c4) = w; }
}

constexpr int CK_SQ = 0, CK_SK = 17408, CK_SQD = 34816, CK_SVT = 52224, CK_SKDT = 70656, CK_CUM = 89088, CK_TOT = 122112, CK_RED = 124160;
DI float lgamma_h(int hd) { return hd == 0 ? -0.031748698314580301f : hd == 1 ? -0.015748356968139168f : hd == 2 ? -0.0078431774610258928f : -0.0039138993211363287f; }

template <int PH>
DI void chunk_item(const int tid, unsigned char* smem, const Params& p, int l, int item) {
    bf16_t* sQ = (bf16_t*)(smem + CK_SQ); bf16_t* sK = (bf16_t*)(smem + CK_SK); bf16_t* sQd = (bf16_t*)(smem + CK_SQD);
    bf16_t* sVt = (bf16_t*)(smem + CK_SVT); bf16_t* sKdT = (bf16_t*)(smem + CK_SKDT);
    float* sCum = (float*)(smem + CK_CUM); float* sTot = (float*)(smem + CK_TOT); float* sRed = (float*)(smem + CK_RED);
    const bf16_t* U = (const bf16_t*)(p.ws + OFF_U); bf16_t* Y = (bf16_t*)(p.ws + OFF_Y);
    const int wid = tid >> 6, lane = tid & 63, l31 = lane & 31, hh = lane >> 5;
    const int mode = item >> 10, rem = item & 1023, b = rem >> 8, hd = (rem >> 6) & 3, n = rem & 63;
    bf16_t* ST = (bf16_t*)(p.ws + (mode == 0 ? OFF_STB : OFF_STC)) + (size_t)rem * 16384;
    const float lg = lgamma_h(hd);
    __syncthreads();
    {
        const int s = tid & 63, wd = tid >> 6; const size_t row = (size_t)b * S_ + n * 64 + s;
        const bf16_t* ur = U + row * LDU;
        if (mode == 0) {
            const int pos = n * 64 + s; const float* rope = (const float*)(p.ws + OFF_ROPE);
            float cs[8], sn[8];
            { const f32x4 c0 = *(const f32x4*)(rope + pos * 64 + wd * 8), c1 = *(const f32x4*)(rope + pos * 64 + wd * 8 + 4);
              const f32x4 s0 = *(const f32x4*)(rope + 4096 * 64 + pos * 64 + wd * 8), s1 = *(const f32x4*)(rope + 4096 * 64 + pos * 64 + wd * 8 + 4);
#pragma unroll
              for (int e = 0; e < 4; ++e) { cs[e] = c0[e]; cs[4 + e] = c1[e]; sn[e] = s0[e]; sn[4 + e] = s1[e]; } }
            float k1[8], k2[8], ka[8], kb[8];
            unpack8(*(const u32x4*)(ur + B_K + hd * 128 + wd * 8), k1); unpack8(*(const u32x4*)(ur + B_K + hd * 128 + 64 + wd * 8), k2);
#pragma unroll
            for (int e = 0; e < 8; ++e) { ka[e] = (k1[e] * cs[e] - k2[e] * sn[e]) * 0.08838834764831845f; kb[e] = (k1[e] * sn[e] + k2[e] * cs[e]) * 0.08838834764831845f; }
            if (PH == 4) {
                float q1[8], q2[8], qa[8], qb[8];
                unpack8(*(const u32x4*)(ur + B_Q + hd * 128 + wd * 8), q1); unpack8(*(const u32x4*)(ur + B_Q + hd * 128 + 64 + wd * 8), q2);
#pragma unroll
                for (int e = 0; e < 8; ++e) { qa[e] = q1[e] * cs[e] - q2[e] * sn[e]; qb[e] = q1[e] * sn[e] + q2[e] * cs[e]; }
                *(bf16x8*)(sQ + s * 136 + wd * 8) = pack8(qa[0], qa[1], qa[2], qa[3], qa[4], qa[5], qa[6], qa[7]);
                *(bf16x8*)(sQ + s * 136 + 64 + wd * 8) = pack8(qb[0], qb[1], qb[2], qb[3], qb[4], qb[5], qb[6], qb[7]);
                const float gqd = __expf(lg * (float)(s + 1));
                *(bf16x8*)(sQd + s * 136 + wd * 8) = pack8(qa[0] * gqd, qa[1] * gqd, qa[2] * gqd, qa[3] * gqd, qa[4] * gqd, qa[5] * gqd, qa[6] * gqd, qa[7] * gqd);
                *(bf16x8*)(sQd + s * 136 + 64 + wd * 8) = pack8(qb[0] * gqd, qb[1] * gqd, qb[2] * gqd, qb[3] * gqd, qb[4] * gqd, qb[5] * gqd, qb[6] * gqd, qb[7] * gqd);
                *(bf16x8*)(sK + s * 136 + wd * 8) = pack8(ka[0], ka[1], ka[2], ka[3], ka[4], ka[5], ka[6], ka[7]);
                *(bf16x8*)(sK + s * 136 + 64 + wd * 8) = pack8(kb[0], kb[1], kb[2], kb[3], kb[4], kb[5], kb[6], kb[7]);
            } else {
                const float gkd = __expf(lg * (float)(63 - s));
#pragma unroll
                for (int e = 0; e < 8; ++e) { sKdT[(wd * 8 + e) * 72 + s] = f2bf(ka[e] * gkd); sKdT[(64 + wd * 8 + e) * 72 + s] = f2bf(kb[e] * gkd); }
            }
            const u32x4 v0 = *(const u32x4*)(ur + B_V + hd * 128 + wd * 16), v1 = *(const u32x4*)(ur + B_V + hd * 128 + wd * 16 + 8);
            const unsigned w[8] = {v0.x, v0.y, v0.z, v0.w, v1.x, v1.y, v1.z, v1.w};
#pragma unroll
            for (int e = 0; e < 8; ++e) { sVt[(wd * 16 + 2 * e) * 72 + s] = (bf16_t)(w[e] & 0xffffu); sVt[(wd * 16 + 2 * e + 1) * 72 + s] = (bf16_t)(w[e] >> 16); }
        } else {
            const int d0 = wd * 16;
            float cf[16], kfv[16];
            unpack8(*(const u32x4*)(ur + C_F + hd * 128 + d0), cf); unpack8(*(const u32x4*)(ur + C_F + hd * 128 + d0 + 8), cf + 8);
#pragma unroll
            for (int e = 0; e < 16; ++e) {
                float lb = 0.f;
                if (l == 1) lb = sigmoidf_(p.lb_logits[512 + hd * 128 + d0 + e] - p.lb_logits[hd * 128 + d0 + e]);
                const float sg = sigmoidf_(cf[e]); const float f = lb + (1.f - lb) * sg;
                kfv[e] = (1.f - lb) * (1.f - sg);
                sCum[s * 129 + d0 + e] = fmaxf(__logf(f), -30.f);
            }
            __syncthreads();
            { const int seg = tid >> 7, d = tid & 127; float run = 0.f;
#pragma unroll
              for (int i = 0; i < 16; ++i) { const int ix = (seg * 16 + i) * 129 + d; run += sCum[ix]; sCum[ix] = run; }
              sTot[seg * 128 + d] = run; }
            __syncthreads();
            { const int seg = tid >> 7, d = tid & 127; float off = 0.f;
              for (int g = 0; g < seg; ++g) off += sTot[g * 128 + d];
              if (seg > 0) {
#pragma unroll
                  for (int i = 0; i < 16; ++i) sCum[(seg * 16 + i) * 129 + d] += off; } }
            __syncthreads();
            if (PH == 4) {
                float q[16];
                unpack8(*(const u32x4*)(ur + C_Q + hd * 128 + d0), q); unpack8(*(const u32x4*)(ur + C_Q + hd * 128 + d0 + 8), q + 8);
                float a[16], kk[16], qd[16];
#pragma unroll
                for (int e = 0; e < 16; ++e) { const float cum = sCum[s * 129 + d0 + e], ref = sCum[31 * 129 + d0 + e];
                    const float dl = fminf(fmaxf(cum - ref, -80.f), 80.f);
                    a[e] = q[e] * __expf(dl); kk[e] = kfv[e] * __expf(-dl); qd[e] = q[e] * __expf(cum); }
                *(bf16x8*)(sQ + s * 136 + d0) = pack8(a[0], a[1], a[2], a[3], a[4], a[5], a[6], a[7]);
                *(bf16x8*)(sQ + s * 136 + d0 + 8) = pack8(a[8], a[9], a[10], a[11], a[12], a[13], a[14], a[15]);
                *(bf16x8*)(sK + s * 136 + d0) = pack8(kk[0], kk[1], kk[2], kk[3], kk[4], kk[5], kk[6], kk[7]);
                *(bf16x8*)(sK + s * 136 + d0 + 8) = pack8(kk[8], kk[9], kk[10], kk[11], kk[12], kk[13], kk[14], kk[15]);
                *(bf16x8*)(sQd + s * 136 + d0) = pack8(qd[0], qd[1], qd[2], qd[3], qd[4], qd[5], qd[6], qd[7]);
                *(bf16x8*)(sQd + s * 136 + d0 + 8) = pack8(qd[8], qd[9], qd[10], qd[11], qd[12], qd[13], qd[14], qd[15]);
            } else {
#pragma unroll
                for (int e = 0; e < 16; ++e) { const float cum = sCum[s * 129 + d0 + e], en = sCum[63 * 129 + d0 + e];
                    sKdT[(d0 + e) * 72 + s] = f2bf(kfv[e] * __expf(en - cum)); }
                if (tid < 128) ((float*)(p.ws + OFF_DEC))[rem * 128 + tid] = __expf(sCum[63 * 129 + tid]);
            }
            const u32x4 v0 = *(const u32x4*)(ur + C_I + hd * 128 + d0), v1 = *(const u32x4*)(ur + C_I + hd * 128 + d0 + 8);
            const unsigned w[8] = {v0.x, v0.y, v0.z, v0.w, v1.x, v1.y, v1.z, v1.w};
#pragma unroll
            for (int e = 0; e < 8; ++e) { sVt[(d0 + 2 * e) * 72 + s] = (bf16_t)(w[e] & 0xffffu); sVt[(d0 + 2 * e + 1) * 72 + s] = (bf16_t)(w[e] >> 16); }
        }
    }
    __syncthreads();
    if (PH == 2) {
        const int vt = wid >> 1, dtb = (wid & 1) * 2;
        f32x16 acc[2]; acc[0] = zero16(); acc[1] = zero16();
#pragma unroll
        for (int s2 = 0; s2 < 4; ++s2) { const bf16x8 af = *(const bf16x8*)(sVt + (32 * vt + l31) * 72 + 16 * s2 + 8 * hh);
#pragma unroll
            for (int j = 0; j < 2; ++j) { const bf16x8 bfr = *(const bf16x8*)(sKdT + (32 * (dtb + j) + l31) * 72 + 16 * s2 + 8 * hh); acc[j] = MFMA32(af, bfr, acc[j]); } }
#pragma unroll
        for (int j = 0; j < 2; ++j)
#pragma unroll
            for (int r = 0; r < 16; ++r) { const int v = 32 * vt + (r & 3) + 8 * (r >> 2) + 4 * hh; ST[v * 128 + 32 * (dtb + j) + l31] = f2bf(acc[j][r]); }
    } else {
        const int tg = wid & 1, vt = wid >> 1, t_idx = 32 * tg + l31;
        f32x16 st[2]; st[0] = zero16(); st[1] = zero16();
#pragma unroll
        for (int s = 0; s < 8; ++s) { const bf16x8 qf = *(const bf16x8*)(sQ + t_idx * 136 + 16 * s + 8 * hh);
#pragma unroll
            for (int mt = 0; mt < 2; ++mt) { const bf16x8 kf = *(const bf16x8*)(sK + (32 * mt + l31) * 136 + 16 * s + 8 * hh); st[mt] = MFMA32(kf, qf, st[mt]); } }
        bf16x8 pb[2][2];
#pragma unroll
        for (int mt = 0; mt < 2; ++mt) {
#pragma unroll
            for (int r = 0; r < 16; ++r) { const int s_idx = 32 * mt + (r & 3) + 8 * (r >> 2) + 4 * hh;
                if (mode == 0) st[mt][r] *= __expf(lg * fabsf((float)(t_idx - s_idx)));
                else st[mt][r] = (s_idx <= t_idx) ? st[mt][r] : 0.f; }
            pb[mt][0] = pack8(st[mt][0], st[mt][1], st[mt][2], st[mt][3], st[mt][4], st[mt][5], st[mt][6], st[mt][7]);
            pb[mt][1] = pack8(st[mt][8], st[mt][9], st[mt][10], st[mt][11], st[mt][12], st[mt][13], st[mt][14], st[mt][15]);
        }
        f32x16 o = zero16();
#pragma unroll
        for (int mt = 0; mt < 2; ++mt)
#pragma unroll
            for (int s2 = 0; s2 < 2; ++s2) { const bf16_t* vr = sVt + (32 * vt + l31) * 72 + 32 * mt + 16 * s2 + 4 * hh;
                const s16x4 lo = *(const s16x4*)vr, hi = *(const s16x4*)(vr + 8);
                o = MFMA32(__builtin_shufflevector(lo, hi, 0, 1, 2, 3, 4, 5, 6, 7), pb[mt][s2], o); }
#pragma unroll
        for (int s = 0; s < 8; ++s) { const bf16x8 af = *(const bf16x8*)(ST + (32 * vt + l31) * 128 + 16 * s + 8 * hh);
            const bf16x8 bq = *(const bf16x8*)(sQd + t_idx * 136 + 16 * s + 8 * hh);
            o = MFMA32(af, bq, o); }
        float ss = 0.f;
#pragma unroll
        for (int r = 0; r < 16; ++r) ss += o[r] * o[r];
        ss += __shfl_xor(ss, 32);
        if (hh == 0) sRed[vt * 64 + t_idx] = ss;
        __syncthreads();
        const float tot = sRed[t_idx] + sRed[64 + t_idx] + sRed[128 + t_idx] + sRed[192 + t_idx];
        const float rstd = rsqrtf(tot * (1.f / 128.f) + 1e-6f);
        const float* gain = (mode == 0 ? p.ret_g : p.hgrn_g) + (l * 4 + hd) * 128;
        const int zoff = mode == 0 ? B_Z : C_Z, brn = mode == 0 ? 1 : 2;
        const size_t row = (size_t)b * S_ + n * 64 + t_idx;
#pragma unroll
        for (int rg = 0; rg < 4; ++rg) { const int v = 32 * vt + 8 * rg + 4 * hh; const f32x4 gg = *(const f32x4*)(gain + v);
            const u32x2 zw = *(const u32x2*)(U + row * LDU + zoff + hd * 128 + v);
            u32x2 w; w.x = pk2(o[4 * rg] * rstd * gg[0] * siluf_(lo16(zw.x)), o[4 * rg + 1] * rstd * gg[1] * siluf_(hi16(zw.x)));
            w.y = pk2(o[4 * rg + 2] * rstd * gg[2] * siluf_(lo16(zw.y)), o[4 * rg + 3] * rstd * gg[3] * siluf_(hi16(zw.y)));
            *(u32x2*)(Y + row * 2048 + brn * 512 + hd * 128 + v) = w; }
    }
}

DI void scan_item(const int tid, const Params& p, int item) {
    const int mode = item >> 7, rem = item & 127, bh = rem >> 3, slice = rem & 7, hd = bh & 3;
    const int e0 = slice * 2048 + tid * 4, d = e0 & 127;
    bf16_t* ST = (bf16_t*)(p.ws + (mode == 0 ? OFF_STB : OFF_STC)) + (size_t)bh * 64 * 16384 + e0;
    const float* DEC = (const float*)(p.ws + OFF_DEC) + (size_t)bh * 64 * 128 + d;
    const float gdec = __expf(lgamma_h(hd) * 64.f);
    f32x4 prev = (f32x4){0.f, 0.f, 0.f, 0.f};
    for (int n0 = 0; n0 < 64; n0 += 8) {
        u32x2 cur[8]; f32x4 dec[8];
#pragma unroll
        for (int i = 0; i < 8; ++i) { cur[i] = *(const u32x2*)(ST + (size_t)(n0 + i) * 16384);
            dec[i] = mode == 0 ? (f32x4){gdec, gdec, gdec, gdec} : *(const f32x4*)(DEC + (n0 + i) * 128); }
#pragma unroll
        for (int i = 0; i < 8; ++i) { u32x2 w; w.x = pk2(prev[0], prev[1]); w.y = pk2(prev[2], prev[3]); *(u32x2*)(ST + (size_t)(n0 + i) * 16384) = w;
            const f32x4 c = {lo16(cur[i].x), hi16(cur[i].x), lo16(cur[i].y), hi16(cur[i].y)}; prev = dec[i] * prev + c; }
    }
}

#define XB_TMO      128
#define XB_XCNT(j)  (256  + 64 * (j))
#define XB_XSUB(j)  (1280 + 64 * (j))
#define XB_XGEN(j)  (2304 + 64 * (j))
#define XB_TOP      3328
#define XB_TOPGEN   3392
#define XB_SPIN_CAP (1u << 18)
DI unsigned xb_ld(unsigned* p) { return __hip_atomic_load(p, __ATOMIC_RELAXED, __HIP_MEMORY_SCOPE_AGENT); }
DI unsigned xb_add(unsigned* p, unsigned v) { return __hip_atomic_fetch_add(p, v, __ATOMIC_RELAXED, __HIP_MEMORY_SCOPE_AGENT); }
DI unsigned xb_xcc_id() { return (unsigned)__builtin_amdgcn_s_getreg((3 << 11) | 20) & 0xFu; }
#define XB_SPIN(cond, bar) do { unsigned _sp = 0; while (cond) { __builtin_amdgcn_s_sleep(1); \
    if ((++_sp & 255u) == 0u) { if (xb_ld(&(bar)[XB_TMO])) break; if (_sp > XB_SPIN_CAP) { atomicAdd(&(bar)[XB_TMO], 1u); break; } } } } while (0)
struct XcdBarrier { unsigned* bar; unsigned x; volatile LAS unsigned* st; };
DI XcdBarrier xcd_barrier_post(unsigned* bar, volatile LAS unsigned* st) {
    XcdBarrier b; b.bar = bar; b.x = xb_xcc_id(); b.st = st;
    if (threadIdx.x == 0) (void)xb_add(&bar[XB_XCNT(b.x)], 1u);
    return b;
}
DI void xcd_barrier_complete(unsigned* bar, unsigned x, unsigned& nloc, unsigned& nx) {
    const unsigned G = gridDim.x * gridDim.y * gridDim.z;
    unsigned sum, cnt, mine, sp = 0u;
    for (;;) {
        sum = 0u; cnt = 0u; mine = 0u;
#pragma unroll
        for (unsigned j = 0; j < 16; ++j) { const unsigned c = xb_ld(&bar[XB_XCNT(j)]); sum += c; cnt += (c > 0u) ? 1u : 0u; mine = (j == x) ? c : mine; }
        if (sum == G) break;
        __builtin_amdgcn_s_sleep(1);
        if ((++sp & 255u) == 0u) { if (xb_ld(&bar[XB_TMO])) break; if (sp > XB_SPIN_CAP) { atomicAdd(&bar[XB_TMO], 1u); break; } }
    }
    nloc = mine > 0u ? mine : 1u; nx = cnt > 0u ? cnt : 1u;
}
DI void xcd_barrier(const XcdBarrier& b) {
    asm volatile("s_waitcnt vmcnt(0)" ::: "memory");
    __syncthreads();
    if (threadIdx.x == 0) {
        unsigned* bar = b.bar;
        __builtin_amdgcn_s_waitcnt(0);
        unsigned nloc = b.st[0], nx = b.st[1];
        if (nloc == 0u) { xcd_barrier_complete(bar, b.x, nloc, nx); b.st[0] = nloc; b.st[1] = nx; }
        const unsigned old = xb_add(&bar[XB_XSUB(b.x)], 1u);
        const unsigned gen = old / nloc;
        if (old + 1u == (gen + 1u) * nloc) {
            __builtin_amdgcn_fence(__ATOMIC_RELEASE, "agent");
            asm volatile("s_waitcnt vmcnt(0)" ::: "memory");
            const unsigned og = xb_add(&bar[XB_TOP], 1u);
            const unsigned tg = og / nx;
            if (og + 1u == (tg + 1u) * nx) xb_add(&bar[XB_TOPGEN], 1u);
            else XB_SPIN(xb_ld(&bar[XB_TOPGEN]) == tg, bar);
            __builtin_amdgcn_fence(__ATOMIC_ACQUIRE, "agent");
            xb_add(&bar[XB_XGEN(b.x)], 1u);
            asm volatile("s_waitcnt vmcnt(0)" ::: "memory");
        } else {
            XB_SPIN(xb_ld(&bar[XB_XGEN(b.x)]) == gen, bar);
            __builtin_amdgcn_fence(__ATOMIC_ACQUIRE, "agent");
            asm volatile("s_waitcnt vmcnt(0)" ::: "memory");
        }
    }
    __syncthreads();
}

#define OPQ() do { asm volatile("" : "+v"(tid)); asm volatile("" : "+s"(bid)); } while (0)
template <int Q>
DI void run_phase(const int l, int tid, int bid, unsigned char* smem, const Params& p) {
    const int G = gridDim.x;
    OPQ();
    if (Q == 0) {
        phase_prep(tid, bid, smem, p, l);
    } else if (Q == 1) {
        { pg8::Gemm g{(const bf16_t*)(p.ws + OFF_H), (const bf16_t*)(p.ws + OFF_WINT), 2048, 2048, T_, G_OFF, 2048};
          pg8::StaticOrder S; S.init(g.M, g.N, G, bid);
          pg8::EpiBf16 E{(bf16_t*)(p.ws + OFF_U), LDU, 1 << 30};
          pg8::gemm_phase(tid, ((LAS unsigned char*)smem), g, S, E); }
        OPQ();
        { pg8::Gemm g{(const bf16_t*)(p.ws + OFF_H), (const bf16_t*)(p.ws + OFF_WINT) + (size_t)G_OFF * 2048, 2048, 2048, T_, 8192, 2048};
          pg8::StaticOrder S; S.init(g.M, g.N, G, bid);
          pg8::EpiGateRatio E{(bf16_t*)(p.ws + OFF_U)};
          pg8::gemm_phase(tid, ((LAS unsigned char*)smem), g, S, E); }
        OPQ();
        { pg8::Gemm g{(const bf16_t*)(p.ws + OFF_MEMB), (const bf16_t*)(p.ws + OFF_WMKV), 2048, 2048, 1024, 1024, 2048};
          pg8::StaticOrder S; S.init(g.M, g.N, G, (bid + G - (3 * G) / 4) % G);
          pg8::EpiBf16 E{(bf16_t*)(p.ws + OFF_MKV), 1024, 1 << 30};
          pg8::gemm_phase(tid, ((LAS unsigned char*)smem), g, S, E); }
    } else if (Q == 2) {
        for (int j = bid; j < 256; j += G) { const int b = j >> 6, c = j & 63; index_item(tid, bid, smem, p, b, c, 0); index_item(tid, bid, smem, p, b, 63 - c, 1); }
        OPQ(); qknorm_pass(tid, bid, p, l);
        OPQ(); for (int j = bid; j < 2048; j += G) chunk_item<2>(tid, smem, p, l, j);
    } else if (Q == 3) {
        for (int j = bid; j < 256; j += G) attnA_item(tid, smem, p, j);
        OPQ(); for (int j = bid; j < 256; j += G) attnM_item(tid, smem, p, j);
        OPQ(); for (int j = bid; j < 256; j += G) scan_item(tid, p, j);
    } else if (Q == 4) {
        for (int j = bid; j < 2048; j += G) chunk_item<4>(tid, smem, p, l, j);
        OPQ(); attnA_finalize(tid, bid, p);
    } else if (Q == 5) {
        pg8::Gemm g{(const bf16_t*)(p.ws + OFF_Y), (const bf16_t*)(p.ws + OFF_WBRT), 2048, 2048, T_, 2048, 2048};
        pg8::StaticOrder S; S.init(g.M, g.N, G, bid);
        pg8::EpiMerged E{(bf16_t*)(p.ws + OFF_H), (const bf16_t*)(p.ws + OFF_U)};
        pg8::HookGate HK{(const bf16_t*)(p.ws + OFF_U)};
        pg8::gemm_phase(tid, ((LAS unsigned char*)smem), g, S, E, HK);
    } else {
        pg8::Gemm g{(const bf16_t*)(p.ws + OFF_H), (const bf16_t*)(p.ws + OFF_WOUT), 2048, 2048, T_, 2048, 2048};
        pg8::StaticOrder S; S.init(g.M, g.N, G, bid);
        pg8::EpiOut E{l == 0 ? p.x : p.out, p.out};
        pg8::gemm_phase(tid, ((LAS unsigned char*)smem), g, S, E);
    }
}

template <int Q>
__global__ __launch_bounds__(512, 2) void mega_one(Params p, int l) {
    extern __shared__ __attribute__((aligned(16))) unsigned char smem[];
    run_phase<Q>(l, threadIdx.x, blockIdx.x, smem, p);
}

#ifndef DUPMASK
#define DUPMASK 0
#endif
#define GSYNC() xcd_barrier(xb)
#define RUNP(Q) do { run_phase<Q>(L, threadIdx.x, blockIdx.x, smem, p); if ((DUPMASK >> Q) & 1) { GSYNC(); run_phase<Q>(L, threadIdx.x, blockIdx.x, smem, p); } } while (0)
template <int L>
DI void run_layer(unsigned char* smem, const Params& p, const XcdBarrier& xb) {
    RUNP(0); GSYNC();
    RUNP(1); GSYNC();
    RUNP(2); GSYNC();
    RUNP(3); GSYNC();
    RUNP(4); GSYNC();
    RUNP(5); GSYNC();
    RUNP(6);
}
__global__ __launch_bounds__(512, 2) void mega_all(Params p) {
    extern __shared__ __attribute__((aligned(16))) unsigned char smem[];
    volatile LAS unsigned* st = (volatile LAS unsigned*)((LAS unsigned char*)smem + 131072);
    if (threadIdx.x == 0) { st[0] = 0u; st[1] = 0u; st[2] = 0u; st[3] = 0u; }
    __syncthreads();
    const XcdBarrier xb = xcd_barrier_post((unsigned*)(p.ws + OFF_BAR), st);
    run_layer<0>(smem, p, xb);
    GSYNC();
    if (p.coop == 0x7fffffff) cg::this_grid().sync();
    run_layer<1>(smem, p, xb);
}

extern "C" void kernel_launch(void* const* d_in, const int* in_sizes, int n_in, void* d_out, int out_size, void* d_ws, size_t ws_size, hipStream_t stream) {
    static int grid = 0;
    if (grid == 0) {
        if (n_in != 11 || ws_size < WS_NEED || out_size != T_ * 2048) { fprintf(stderr, "kernel_launch: unexpected sizes n_in=%d ws=%zu need=%zu out=%d\n", n_in, ws_size, (size_t)WS_NEED, out_size); grid = -1; return; }
        int dev = 0, cus = 0, per_cu = 0;
        (void)hipGetDevice(&dev); (void)hipDeviceGetAttribute(&cus, hipDeviceAttributeMultiprocessorCount, dev);
#if MULTI_LAUNCH
        (void)hipFuncSetAttribute((const void*)mega_one<0>, hipFuncAttributeMaxDynamicSharedMemorySize, LDS_BYTES); (void)hipFuncSetAttribute((const void*)mega_one<1>, hipFuncAttributeMaxDynamicSharedMemorySize, LDS_BYTES);
        (void)hipFuncSetAttribute((const void*)mega_one<2>, hipFuncAttributeMaxDynamicSharedMemorySize, LDS_BYTES); (void)hipFuncSetAttribute((const void*)mega_one<3>, hipFuncAttributeMaxDynamicSharedMemorySize, LDS_BYTES);
        (void)hipFuncSetAttribute((const void*)mega_one<4>, hipFuncAttributeMaxDynamicSharedMemorySize, LDS_BYTES); (void)hipFuncSetAttribute((const void*)mega_one<5>, hipFuncAttributeMaxDynamicSharedMemorySize, LDS_BYTES);
        (void)hipFuncSetAttribute((const void*)mega_one<6>, hipFuncAttributeMaxDynamicSharedMemorySize, LDS_BYTES);
#else
        if (hipFuncSetAttribute((const void*)mega_all, hipFuncAttributeMaxDynamicSharedMemorySize, LDS_BYTES) != hipSuccess) { fprintf(stderr, "kernel_launch: hipFuncSetAttribute failed\n"); grid = -1; return; }
        (void)hipOccupancyMaxActiveBlocksPerMultiprocessor(&per_cu, (const void*)mega_all, 512, LDS_BYTES);
        if (per_cu < 1) { fprintf(stderr, "kernel_launch: occupancy query says %d blocks per CU\n", per_cu); per_cu = 1; }
#endif
        (void)hipGetLastError();
        grid = cus < 256 ? cus : 256;
    }
    if (grid < 0) return;
    Params p{};
    p.x = (const float*)d_in[0]; p.mem = (const float*)d_in[1]; p.norm_g = (const float*)d_in[2]; p.w_in = (const float*)d_in[3]; p.qk_g = (const float*)d_in[4];
    p.ret_g = (const float*)d_in[5]; p.hgrn_g = (const float*)d_in[6]; p.lb_logits = (const float*)d_in[7]; p.w_mem_kv = (const float*)d_in[8]; p.w_branch = (const float*)d_in[9]; p.w_out = (const float*)d_in[10];
    p.out = (float*)d_out; p.ws = (unsigned char*)d_ws; p.pad = 0;
#if MULTI_LAUNCH
    for (int ph = 0; ph < NPH; ++ph) { const int l = ph / 7;
        switch (ph % 7) {
            case 0: hipLaunchKernelGGL(mega_one<0>, dim3(grid), dim3(512), LDS_BYTES, stream, p, l); break;
            case 1: hipLaunchKernelGGL(mega_one<1>, dim3(grid), dim3(512), LDS_BYTES, stream, p, l); break;
            case 2: hipLaunchKernelGGL(mega_one<2>, dim3(grid), dim3(512), LDS_BYTES, stream, p, l); break;
            case 3: hipLaunchKernelGGL(mega_one<3>, dim3(grid), dim3(512), LDS_BYTES, stream, p, l); break;
            case 4: hipLaunchKernelGGL(mega_one<4>, dim3(grid), dim3(512), LDS_BYTES, stream, p, l); break;
            case 5: hipLaunchKernelGGL(mega_one<5>, dim3(grid), dim3(512), LDS_BYTES, stream, p, l); break;
            default: hipLaunchKernelGGL(mega_one<6>, dim3(grid), dim3(512), LDS_BYTES, stream, p, l); break;
        } }
#else
    p.ph_lo = 0; p.ph_hi = NPH; p.coop = 1;
    if (hipMemsetAsync((char*)d_ws + OFF_BAR, 0, BAR_BYTES, stream) != hipSuccess) { fprintf(stderr, "kernel_launch: hipMemsetAsync of the barrier words failed\n"); return; }
    void* args[] = {&p};
    hipError_t e = hipLaunchCooperativeKernel((const void*)mega_all, dim3(grid), dim3(512), args, LDS_BYTES, stream);
    if (e != hipSuccess) fprintf(stderr, "cooperative launch failed: %s (grid %d)\n", hipGetErrorString(e), grid);
#endif
}
```

```cpp
#include <hip/hip_runtime.h>
#include <hip/hip_cooperative_groups.h>
#include <cstdio>
namespace cg = cooperative_groups;

#ifndef PHMASK
#define PHMASK 127
#endif
#ifndef P2SEL
#define P2SEL 7
#endif
#ifndef MULTI_LAUNCH
#define MULTI_LAUNCH 0
#endif

#define DI __device__ __forceinline__
#define LAS __attribute__((address_space(3)))
typedef unsigned short bf16_t;
typedef short bf16x8 __attribute__((ext_vector_type(8)));
typedef short s16x4 __attribute__((ext_vector_type(4)));
typedef float f32x4 __attribute__((ext_vector_type(4)));
typedef float f32x16 __attribute__((ext_vector_type(16)));
typedef unsigned u32x4 __attribute__((ext_vector_type(4)));
typedef unsigned u32x2 __attribute__((ext_vector_type(2)));
typedef unsigned long long u64;

constexpr int T_ = 16384, S_ = 4096, LDU = 16128;
constexpr int A_Q = 0, A_K = 512, A_V = 1024, A_Z = 1536, A_QI = 2048, A_KI = 2560, A_WI = 2624;
constexpr int B_Q = 2816, B_K = 3328, B_V = 3840, B_Z = 4352, C_F = 4864, C_I = 5376, C_Q = 5888, C_Z = 6400, M_Q = 6912, M_Z = 7424, G_OFF = 7936;
constexpr int IN_W = 15944;
constexpr int NPH = 14;

constexpr size_t OFF_WINT = 0;
constexpr size_t OFF_WBRT = OFF_WINT + (size_t)LDU * 2048 * 2;
constexpr size_t OFF_WOUT = OFF_WBRT + (size_t)2048 * 2048 * 2;
constexpr size_t OFF_WMKV = OFF_WOUT + (size_t)2048 * 2048 * 2;
constexpr size_t OFF_MEMB = OFF_WMKV + (size_t)1024 * 2048 * 2;
constexpr size_t OFF_MKV = OFF_MEMB + (size_t)1024 * 2048 * 2;
constexpr size_t OFF_H = OFF_MKV + (size_t)1024 * 1024 * 2;
constexpr size_t OFF_U = OFF_H + (size_t)T_ * 2048 * 2;
constexpr size_t OFF_Y = OFF_U + (size_t)T_ * LDU * 2;
constexpr size_t OFF_R1 = OFF_Y + (size_t)T_ * 2048 * 2;
constexpr size_t OFF_STB = OFF_R1 + (size_t)T_ * 2048 * 4;
constexpr size_t OFF_STC = OFF_STB + (size_t)1024 * 16384 * 4;
constexpr size_t OFF_DEC = OFF_STC + (size_t)1024 * 16384 * 4;
constexpr size_t OFF_MASK = OFF_DEC + (size_t)1024 * 128 * 4;
constexpr size_t OFF_ROPE = OFF_MASK + (size_t)T_ * 64 * 8;
constexpr size_t WS_END = OFF_ROPE + (size_t)2 * 4096 * 64 * 4;
constexpr size_t OFF_BAR = WS_END;
constexpr size_t BAR_BYTES = 3456 * 4;
constexpr size_t WS_NEED = OFF_BAR + BAR_BYTES;
constexpr int LDS_BYTES = 131072 + 16;

struct Params {
    const float *x, *mem, *norm_g, *w_in, *qk_g, *ret_g, *hgrn_g, *lb_logits, *w_mem_kv, *w_branch, *w_out;
    float* out;
    unsigned char* ws;
    int ph_lo, ph_hi, coop, pad;
};

DI float bf2f(bf16_t b) { return __uint_as_float(((unsigned)b) << 16); }
typedef __bf16 hbf16x2 __attribute__((ext_vector_type(2)));
typedef float f32x2 __attribute__((ext_vector_type(2)));
DI unsigned pk2(float lo, float hi) { const f32x2 v = {lo, hi}; return __builtin_bit_cast(unsigned, __builtin_convertvector(v, hbf16x2)); }
DI bf16_t f2bf(float x) { return (bf16_t)(pk2(x, 0.f) & 0xffffu); }
DI float lo16(unsigned w) { return __uint_as_float(w << 16); }
DI float hi16(unsigned w) { return __uint_as_float(w & 0xffff0000u); }
DI float sigmoidf_(float x) { return 1.0f / (1.0f + __expf(-x)); }
DI float siluf_(float x) { return x / (1.0f + __expf(-x)); }
DI f32x16 zero16() { f32x16 z; for (int i = 0; i < 16; ++i) z[i] = 0.f; return z; }
#define MFMA32(a, b, c) __builtin_amdgcn_mfma_f32_32x32x16_bf16((a), (b), (c), 0, 0, 0)
DI bf16x8 pack8(float a0, float a1, float a2, float a3, float a4, float a5, float a6, float a7) {
    u32x4 w; w.x = pk2(a0, a1); w.y = pk2(a2, a3); w.z = pk2(a4, a5); w.w = pk2(a6, a7);
    return __builtin_bit_cast(bf16x8, w);
}
DI void unpack8(const u32x4 w, float* f) {
    f[0] = lo16(w.x); f[1] = hi16(w.x); f[2] = lo16(w.y); f[3] = hi16(w.y); f[4] = lo16(w.z); f[5] = hi16(w.z); f[6] = lo16(w.w); f[7] = hi16(w.w);
}

namespace pg8 {
constexpr int BM = 256, BK = 64, HALF = 128, HTB = HALF * BK * 2, NXCD = 8, WGM = 8;
DI int lds_byte(int r, int c) { const int st = (r >> 4) * 2 + (c >> 5), rr = r & 15, cc = c & 31, ob = rr * 64 + cc * 2; return st * 1024 + (ob ^ (((ob >> 9) & 1) << 5)); }
DI void stage_rc(int b, int& R, int& C) { const int st = b / 1024, sb = b % 1024, swz = sb ^ (((sb >> 9) & 1) << 5); R = (st >> 1) * 16 + swz / 64; C = (st & 1) * 32 + (swz % 64) / 2; }
DI int perm32(int rho) { const int n = rho >> 4, i = rho & 15; return 8 * (i >> 2) + 4 * n + (i & 3); }
struct Unit { int pm, pn; };
struct Gemm { const bf16_t* A; const bf16_t* Bt; int lda, ldb, M, N, K; };
struct StaticOrder {
    int nM, nN, nwg, G, c;
    DI void init(int M, int N, int G_, int c_) { nM = M / BM; nN = N / BM; nwg = nM * nN; G = G_; c = c_; }
    DI bool next(int i, Unit& u) const {
        const long L = (long)i * G + c; if (L >= nwg) return false;
        int wgid = (int)L; { const int q = nwg / NXCD, r = nwg % NXCD, xcd = wgid % NXCD, off = wgid / NXCD; wgid = (xcd < r ? xcd * (q + 1) : r * (q + 1) + (xcd - r) * q) + off; }
        const int nig = WGM * nN, gid = wgid / nig, fm = gid * WGM, gsz = (nM - fm) < WGM ? (nM - fm) : WGM;
        u.pm = fm + ((wgid % nig) % gsz); u.pn = (wgid % nig) / gsz; return true;
    }
};

struct NoHook { static constexpr bool ON = false; DI void operator()(f32x4 (&)[2][2][4][2], const Unit&, int, int, int, int, int) const {} };
template <class Epi, class Hook = NoHook>
DI void gemm_phase(const int tid, LAS unsigned char* lds, const Gemm g, const StaticOrder& S, const Epi& E, const Hook& HK = Hook()) {
    const int wid = __builtin_amdgcn_readfirstlane(tid >> 6), lane = tid & 63, wr = wid >> 2, wc = wid & 3, fr = lane & 15, fq = lane >> 4;
    const int K = g.K, nt = K / BK;
    unsigned voffA[2], voffB[2];
#pragma unroll
    for (int i = 0; i < 2; ++i) { int R, C; stage_rc(tid * 16 + i * 8192, R, C); const int Rb = Epi::PERM ? ((R & ~31) + perm32(R & 31)) : R;
        voffA[i] = (unsigned)(R * g.lda + C) * 2u; voffB[i] = (unsigned)(Rb * g.ldb + C) * 2u; }
    const size_t kstep = (size_t)(BK * 2);
    const size_t hstepA = (size_t)HALF * g.lda * 2, hstepB = (size_t)HALF * g.ldb * 2;
    const size_t tstepA = 2 * hstepA, tstepB = 2 * hstepB;
    const unsigned ldsw = (unsigned)wid * 1024u;
    const int aoff = lds_byte(wr * 64 + fr, fq * 8), boff = lds_byte(wc * 32 + fr, fq * 8);
#define PG8_SA(b, h) (((b) * 2 + (h)) * HTB)
#define PG8_SB(b, h) ((4 + (b) * 2 + (h)) * HTB)
#define PG8_STAGE(bufoff, gbase, voff) do { _Pragma("unroll") for (int _i = 0; _i < 2; ++_i) \
        __builtin_amdgcn_global_load_lds((const unsigned*)((const char*)(gbase) + (voff)[_i]), (LAS unsigned*)(lds + (bufoff) + ldsw + _i * 8192), 16, 0, 0); } while (0)
#define PG8_LDA(dst, b, h) do { _Pragma("unroll") for (int m = 0; m < 4; ++m) _Pragma("unroll") for (int k = 0; k < 2; ++k) dst[m][k] = *(const LAS bf16x8*)(lds + PG8_SA(b, h) + aoff + m * 2048 + k * 1024); } while (0)
#define PG8_LDB(dst, b, h) do { _Pragma("unroll") for (int n = 0; n < 2; ++n) _Pragma("unroll") for (int k = 0; k < 2; ++k) dst[n][k] = *(const LAS bf16x8*)(lds + PG8_SB(b, h) + boff + n * 2048 + k * 1024); } while (0)
#define PG8_MMA(ai, bj, At, Bt) do { __builtin_amdgcn_s_setprio(1); _Pragma("unroll") for (int m = 0; m < 4; ++m) _Pragma("unroll") for (int n = 0; n < 2; ++n) _Pragma("unroll") for (int k = 0; k < 2; ++k) \
        acc[ai][bj][m][n] = __builtin_amdgcn_mfma_f32_16x16x32_bf16(Bt[n][k], At[m][k], acc[ai][bj][m][n], 0, 0, 0); __builtin_amdgcn_s_setprio(0); } while (0)
#define PG8_WAIT_V(n) asm volatile("s_waitcnt vmcnt(" #n ")" ::: "memory")
#define PG8_WAIT_L(n) asm volatile("s_waitcnt lgkmcnt(" #n ")" ::: "memory")
#define PG8_BAR __builtin_amdgcn_s_barrier()
#define PG8_SCHED __builtin_amdgcn_sched_barrier(0)
    Unit cur, nxt; int ui = 0;
    if (!S.next(0, cur)) return;
    f32x4 acc[2][2][4][2];
#pragma unroll
    for (int a = 0; a < 2; ++a)
#pragma unroll
        for (int b = 0; b < 2; ++b)
#pragma unroll
            for (int m = 0; m < 4; ++m)
#pragma unroll
                for (int n = 0; n < 2; ++n) acc[a][b][m][n] = (f32x4){0.f, 0.f, 0.f, 0.f};
    bf16x8 At[4][2], B0[2][2], B1[2][2];
    const char* cA = (const char*)g.A + (size_t)cur.pm * tstepA; const char* cB = (const char*)g.Bt + (size_t)cur.pn * tstepB;
    PG8_STAGE(PG8_SB(0, 0), cB, voffB); PG8_STAGE(PG8_SA(0, 0), cA, voffA); PG8_STAGE(PG8_SB(0, 1), cB + hstepB, voffB); PG8_STAGE(PG8_SA(0, 1), cA + hstepA, voffA);
    if (wr == 1) PG8_BAR;
    PG8_WAIT_V(4); PG8_BAR;
    PG8_STAGE(PG8_SB(1, 0), cB + kstep, voffB); PG8_STAGE(PG8_SA(1, 0), cA + kstep, voffA); PG8_STAGE(PG8_SB(1, 1), cB + hstepB + kstep, voffB);
    PG8_WAIT_V(6); PG8_BAR;
    for (;;) {
        const bool has_next = S.next(ui + 1, nxt);
        const char* nA = has_next ? (const char*)g.A + (size_t)nxt.pm * tstepA : cA; const char* nB = has_next ? (const char*)g.Bt + (size_t)nxt.pn * tstepB : cB;
        for (int t = 0; t < nt; t += 2) {
            const bool last = (t == nt - 2);
            const char* a1 = cA + (size_t)(t + 1) * kstep;
            const char* a2 = last ? nA : cA + (size_t)(t + 2) * kstep; const char* b2 = last ? nB : cB + (size_t)(t + 2) * kstep;
            const char* a3 = a2 + kstep; const char* b3 = b2 + kstep;
            PG8_LDB(B0, 0, 0); PG8_SCHED; PG8_LDA(At, 0, 0); PG8_STAGE(PG8_SA(1, 1), a1 + hstepA, voffA);
            PG8_WAIT_L(8); PG8_BAR; PG8_WAIT_L(0); PG8_MMA(0, 0, At, B0); PG8_BAR; PG8_SCHED;
            PG8_LDB(B1, 0, 1); PG8_STAGE(PG8_SB(0, 0), b2, voffB);
            PG8_BAR; PG8_WAIT_L(0); PG8_MMA(0, 1, At, B1); PG8_BAR;
            PG8_LDA(At, 0, 1); PG8_STAGE(PG8_SA(0, 0), a2, voffA);
            PG8_BAR; PG8_WAIT_L(0); PG8_MMA(1, 0, At, B0); PG8_BAR; PG8_SCHED;
            PG8_STAGE(PG8_SB(0, 1), b2 + hstepB, voffB);
            PG8_WAIT_V(6); PG8_BAR; PG8_MMA(1, 1, At, B1); PG8_BAR;
            PG8_LDB(B0, 1, 0); PG8_SCHED; PG8_LDA(At, 1, 0); PG8_STAGE(PG8_SA(0, 1), a2 + hstepA, voffA);
            PG8_WAIT_L(8); PG8_BAR; PG8_WAIT_L(0); PG8_MMA(0, 0, At, B0); PG8_BAR; PG8_SCHED;
            PG8_LDB(B1, 1, 1); PG8_STAGE(PG8_SB(1, 0), b3, voffB);
            PG8_BAR; PG8_WAIT_L(0); PG8_MMA(0, 1, At, B1); PG8_BAR;
            PG8_LDA(At, 1, 1); PG8_STAGE(PG8_SA(1, 0), a3, voffA);
            PG8_BAR; PG8_WAIT_L(0); PG8_MMA(1, 0, At, B0); PG8_BAR; PG8_SCHED;
            PG8_STAGE(PG8_SB(1, 1), b3 + hstepB, voffB);
            PG8_WAIT_V(6); PG8_BAR; PG8_MMA(1, 1, At, B1); PG8_BAR;
            if (Hook::ON) { PG8_SCHED; HK(acc, cur, t, wr, wc, fr, fq); PG8_SCHED; }
        }
        E(acc, cur, wr, wc, fr, fq);
        if (!has_next) break;
#pragma unroll
        for (int a = 0; a < 2; ++a)
#pragma unroll
            for (int b = 0; b < 2; ++b)
#pragma unroll
                for (int m = 0; m < 4; ++m)
#pragma unroll
                    for (int n = 0; n < 2; ++n) acc[a][b][m][n] = (f32x4){0.f, 0.f, 0.f, 0.f};
        cur = nxt; cA = nA; cB = nB; ++ui;
    }
    PG8_WAIT_V(0);
    if (wr == 0) PG8_BAR;
    PG8_BAR;
#undef PG8_SA
#undef PG8_SB
#undef PG8_STAGE
#undef PG8_LDA
#undef PG8_LDB
#undef PG8_MMA
#undef PG8_WAIT_V
#undef PG8_WAIT_L
#undef PG8_BAR
#undef PG8_SCHED
}

struct EpiBf16 {
    static constexpr bool PERM = true;
    bf16_t* O; int ldc; int sig_pn;
    DI void operator()(const f32x4 (&acc)[2][2][4][2], const Unit& u, int wr, int wc, int fr, int fq) const {
        const int row0 = u.pm * BM + wr * 64 + fr, col0 = u.pn * BM + wc * 32 + 8 * fq;
        const bool sg = u.pn >= sig_pn;
#pragma unroll
        for (int ai = 0; ai < 2; ++ai)
#pragma unroll
            for (int m = 0; m < 4; ++m) { bf16_t* rowp = O + (size_t)(row0 + ai * HALF + m * 16) * ldc + col0;
#pragma unroll
                for (int bj = 0; bj < 2; ++bj) { f32x4 v0 = acc[ai][bj][m][0], v1 = acc[ai][bj][m][1];
                    if (sg) {
#pragma unroll
                        for (int j = 0; j < 4; ++j) { v0[j] = sigmoidf_(v0[j]); v1[j] = sigmoidf_(v1[j]); } }
                    u32x4 w; w.x = pk2(v0[0], v0[1]); w.y = pk2(v0[2], v0[3]); w.z = pk2(v1[0], v1[1]); w.w = pk2(v1[2], v1[3]);
                    *(u32x4*)(rowp + bj * HALF) = w; }
                __builtin_amdgcn_sched_barrier(0); }
    }
};
struct EpiGateRatio {
    static constexpr bool PERM = false;
    bf16_t* U;
    DI void operator()(const f32x4 (&acc)[2][2][4][2], const Unit& u, int wr, int wc, int fr, int fq) const {
        const int row0 = u.pm * BM + wr * 64 + fr, c0 = u.pn * 64 + 16 * wc + 4 * fq;
#pragma unroll
        for (int ai = 0; ai < 2; ++ai)
#pragma unroll
            for (int m = 0; m < 4; ++m) { bf16_t* rowp = U + (size_t)(row0 + ai * HALF + m * 16) * LDU + G_OFF + c0;
                float r0[4], r1[4], r2[4], g3[4];
#pragma unroll
                for (int j = 0; j < 4; ++j) { const float e0 = __expf(-acc[ai][0][m][0][j]), e1 = __expf(-acc[ai][0][m][1][j]), e2 = __expf(-acc[ai][1][m][0][j]), e3 = __expf(-acc[ai][1][m][1][j]);
                    const float i0 = __builtin_amdgcn_rcpf(1.0f + e0), i1 = __builtin_amdgcn_rcpf(1.0f + e1), i2 = __builtin_amdgcn_rcpf(1.0f + e2), i3 = __builtin_amdgcn_rcpf(1.0f + e3);
                    r0[j] = (1.0f + e1) * i0; r1[j] = (1.0f + e2) * i1; r2[j] = (1.0f + e3) * i2; g3[j] = i3; }
                u32x2 w;
                w.x = pk2(r0[0], r0[1]); w.y = pk2(r0[2], r0[3]); *(u32x2*)(rowp) = w;
                w.x = pk2(r1[0], r1[1]); w.y = pk2(r1[2], r1[3]); *(u32x2*)(rowp + 2048) = w;
                w.x = pk2(r2[0], r2[1]); w.y = pk2(r2[2], r2[3]); *(u32x2*)(rowp + 4096) = w;
                w.x = pk2(g3[0], g3[1]); w.y = pk2(g3[2], g3[3]); *(u32x2*)(rowp + 6144) = w;
                __builtin_amdgcn_sched_barrier(0); }
    }
};
struct HookGate {
    static constexpr bool ON = true;
    const bf16_t* U;
    DI void operator()(f32x4 (&acc)[2][2][4][2], const Unit& u, int t, int wr, int wc, int fr, int fq) const {
        if ((t & 7) != 6 || t >= 24) return;
        const int seg = t >> 3;
        int row0 = u.pm * BM + wr * 64 + fr, col0 = u.pn * BM + wc * 32 + 8 * fq;
        asm volatile("" : "+v"(row0), "+v"(col0));
#pragma unroll
        for (int ai = 0; ai < 2; ++ai) {
            u32x4 ga[4][2];
#pragma unroll
            for (int m = 0; m < 4; ++m) { const bf16_t* gp = U + (size_t)(row0 + ai * HALF + m * 16) * LDU + G_OFF + seg * 2048 + col0;
#pragma unroll
                for (int bj = 0; bj < 2; ++bj) ga[m][bj] = *(const u32x4*)(gp + bj * HALF); }
#pragma unroll
            for (int m = 0; m < 4; ++m)
#pragma unroll
                for (int bj = 0; bj < 2; ++bj) { const u32x4 a = ga[m][bj];
                    f32x4& v0 = acc[ai][bj][m][0]; f32x4& v1 = acc[ai][bj][m][1];
                    v0[0] *= lo16(a.x); v0[1] *= hi16(a.x); v0[2] *= lo16(a.y); v0[3] *= hi16(a.y);
                    v1[0] *= lo16(a.z); v1[1] *= hi16(a.z); v1[2] *= lo16(a.w); v1[3] *= hi16(a.w); }
            __builtin_amdgcn_sched_barrier(0); }
    }
};
struct EpiMerged {
    static constexpr bool PERM = true;
    bf16_t* Mb; const bf16_t* U;
    DI void operator()(const f32x4 (&acc)[2][2][4][2], const Unit& u, int wr, int wc, int fr, int fq) const {
        const int row0 = u.pm * BM + wr * 64 + fr, col0 = u.pn * BM + wc * 32 + 8 * fq;
#pragma unroll
        for (int ai = 0; ai < 2; ++ai) {
            u32x4 gw[4][2];
#pragma unroll
            for (int m = 0; m < 4; ++m) { const size_t row = (size_t)(row0 + ai * HALF + m * 16);
#pragma unroll
                for (int bj = 0; bj < 2; ++bj) gw[m][bj] = *(const u32x4*)(U + row * LDU + G_OFF + 3 * 2048 + col0 + bj * HALF); }
#pragma unroll
            for (int m = 0; m < 4; ++m) { const size_t row = (size_t)(row0 + ai * HALF + m * 16);
#pragma unroll
                for (int bj = 0; bj < 2; ++bj) { const u32x4 g = gw[m][bj]; const f32x4 v0 = acc[ai][bj][m][0], v1 = acc[ai][bj][m][1];
                    u32x4 w; w.x = pk2(v0[0] * lo16(g.x), v0[1] * hi16(g.x)); w.y = pk2(v0[2] * lo16(g.y), v0[3] * hi16(g.y));
                    w.z = pk2(v1[0] * lo16(g.z), v1[1] * hi16(g.z)); w.w = pk2(v1[2] * lo16(g.w), v1[3] * hi16(g.w));
                    *(u32x4*)(Mb + row * 2048 + col0 + bj * HALF) = w; } }
            __builtin_amdgcn_sched_barrier(0); }
    }
};
struct EpiOut {
    static constexpr bool PERM = false;
    const float* xin; float* out;
    DI void operator()(const f32x4 (&acc)[2][2][4][2], const Unit& u, int wr, int wc, int fr, int fq) const {
        const int row0 = u.pm * BM + wr * 64 + fr, col0 = u.pn * BM + wc * 32 + 4 * fq;
#pragma unroll
        for (int ai = 0; ai < 2; ++ai) {
            f32x4 xv[4][4];
#pragma unroll
            for (int m = 0; m < 4; ++m) { const size_t row = (size_t)(row0 + ai * HALF + m * 16);
#pragma unroll
                for (int bj = 0; bj < 2; ++bj)
#pragma unroll
                    for (int n = 0; n < 2; ++n) xv[m][bj * 2 + n] = *(const f32x4*)(xin + row * 2048 + col0 + bj * HALF + n * 16); }
#pragma unroll
            for (int m = 0; m < 4; ++m) { const size_t row = (size_t)(row0 + ai * HALF + m * 16);
#pragma unroll
                for (int bj = 0; bj < 2; ++bj)
#pragma unroll
                    for (int n = 0; n < 2; ++n) *(f32x4*)(out + row * 2048 + col0 + bj * HALF + n * 16) = xv[m][bj * 2 + n] + acc[ai][bj][m][n]; }
            __builtin_amdgcn_sched_barrier(0); }
    }
};
}

DI void tr_tile(const int tid, bf16_t* sT, const float* __restrict__ src, int ld_src, int k0, int n0, bf16_t* __restrict__ dst, int ld_dst, int koff, bool winmap) {
    const int n4 = (tid & 31) * 4, kb = tid >> 5;
    const int n = n0 + n4; int sc = n;
    if (winmap) {
        if (n < G_OFF) sc = (n < 2632) ? n : (n < 2816 ? -1 : n - 184);
        else {
            const int t = n - G_OFF, tc = t & 255, bj = tc >> 7, wc = (tc >> 5) & 3, n1 = (tc >> 4) & 1, fq = (tc >> 2) & 3;
            sc = (G_OFF - 184) + (2 * bj + n1) * 2048 + 64 * (t >> 8) + 16 * wc + 4 * fq; }
    }
    f32x4 v[4];
#pragma unroll
    for (int i = 0; i < 4; ++i) v[i] = (sc >= 0) ? *(const f32x4*)(src + (size_t)(k0 + i * 16 + kb) * ld_src + sc) : (f32x4){0.f, 0.f, 0.f, 0.f};
#pragma unroll
    for (int i = 0; i < 4; ++i)
#pragma unroll
        for (int e = 0; e < 4; ++e) sT[(n4 + e) * 66 + i * 16 + kb] = f2bf(v[i][e]);
    __syncthreads();
#pragma unroll
    for (int h = 0; h < 2; ++h) { const int n2 = (tid >> 3) + h * 64, kc = (tid & 7) * 8; const unsigned* sp = (const unsigned*)(sT + n2 * 66 + kc);
        u32x4 w; w.x = sp[0]; w.y = sp[1]; w.z = sp[2]; w.w = sp[3];
        *(u32x4*)(dst + (size_t)(n0 + n2) * ld_dst + koff + k0 + kc) = w; }
    __syncthreads();
}

DI void phase_prep(const int tid, const int bid, unsigned char* smem, const Params& p, int l) {
    bf16_t* sT = (bf16_t*)smem;
    const int G = gridDim.x, wid = tid >> 6, lane = tid & 63;
    bf16_t* WinT = (bf16_t*)(p.ws + OFF_WINT); bf16_t* WbrT = (bf16_t*)(p.ws + OFF_WBRT); bf16_t* WoutT = (bf16_t*)(p.ws + OFF_WOUT); bf16_t* WmkvT = (bf16_t*)(p.ws + OFF_WMKV);
    for (int t = bid; t < 4032 + 512 + 512 + 256; t += G) {
        if (t < 4032) { const int kt = t & 31, ntl = t >> 5; tr_tile(tid, sT, p.w_in + (size_t)l * 2048 * IN_W, IN_W, kt * 64, ntl * 128, WinT, 2048, 0, true); }
        else if (t < 4544) { const int u = t - 4032, nb = u >> 7, rem = u & 127, kt = rem & 7, ct = rem >> 3;
            tr_tile(tid, sT, p.w_branch + ((size_t)(l * 4 + nb) * 512) * 2048, 2048, kt * 64, ct * 128, WbrT, 2048, nb * 512, false); }
        else if (t < 5056) { const int u = t - 4544, kt = u & 31, ntl = u >> 5; tr_tile(tid, sT, p.w_out + (size_t)l * 2048 * 2048, 2048, kt * 64, ntl * 128, WoutT, 2048, 0, false); }
        else { const int u = t - 5056, kt = u & 31, ntl = u >> 5; tr_tile(tid, sT, p.w_mem_kv + (size_t)l * 2048 * 1024, 1024, kt * 64, ntl * 128, WmkvT, 2048, 0, false); }
    }
    const float* xin = l == 0 ? p.x : p.out; const float* g = p.norm_g + l * 2048; bf16_t* H = (bf16_t*)(p.ws + OFF_H);
    for (int row = bid * 8 + wid; row < T_; row += G * 8) {
        const float* xr = xin + (size_t)row * 2048; f32x4 v[8]; float ss = 0.f;
#pragma unroll
        for (int i = 0; i < 8; ++i) { v[i] = *(const f32x4*)(xr + i * 256 + lane * 4); ss += v[i][0] * v[i][0] + v[i][1] * v[i][1] + v[i][2] * v[i][2] + v[i][3] * v[i][3]; }
#pragma unroll
        for (int m = 32; m >= 1; m >>= 1) ss += __shfl_xor(ss, m);
        const float rs = rsqrtf(ss * (1.f / 2048.f) + 1e-6f);
#pragma unroll
        for (int i = 0; i < 8; ++i) { const f32x4 gg = *(const f32x4*)(g + i * 256 + lane * 4); u32x2 w; w.x = pk2(v[i][0] * rs * gg[0], v[i][1] * rs * gg[1]); w.y = pk2(v[i][2] * rs * gg[2], v[i][3] * rs * gg[3]);
            *(u32x2*)(H + (size_t)row * 2048 + i * 256 + lane * 4) = w; }
    }
    if (l == 0) {
        bf16_t* memb = (bf16_t*)(p.ws + OFF_MEMB);
        for (int i = bid * 512 + tid; i < 1024 * 2048 / 4; i += G * 512) { const f32x4 v = *(const f32x4*)(p.mem + (size_t)i * 4); u32x2 w; w.x = pk2(v[0], v[1]); w.y = pk2(v[2], v[3]); *(u32x2*)(memb + (size_t)i * 4) = w; }
        float* rope = (float*)(p.ws + OFF_ROPE);
        for (int i = bid * 512 + tid; i < 4096 * 64; i += G * 512) { const int pos = i >> 6, fi = i & 63;
            const float inv = __builtin_amdgcn_exp2f(-(float)fi * (13.287712379549449f / 64.f));
            const float ang = (float)pos * inv;
            const double rev = (double)ang * 0.15915494309189535; const float fr = (float)(rev - floor(rev));
            rope[i] = __builtin_amdgcn_cosf(fr); rope[4096 * 64 + i] = __builtin_amdgcn_sinf(fr); }
    }
}

template <int K>
DI u64 select_row(const float* __restrict__ rowp, const int nvalid  , unsigned* sS, const int lane) {
    unsigned key[K];
    const bool act = lane * K < nvalid;
    const float* sp = rowp + (act ? lane : 0) * K;
#pragma unroll
    for (int j4 = 0; j4 < K / 4; ++j4) { const f32x4 v4 = *(const f32x4*)(sp + 4 * j4);
#pragma unroll
        for (int e = 0; e < 4; ++e) { const float v = v4[e] + 0.0f; const unsigned u = __float_as_uint(v); const unsigned k = (u & 0x80000000u) ? ~u : (u | 0x80000000u); key[4 * j4 + e] = act ? k : 0u; } }
#define COUNT_GE(cand_, out_) do { int cs_ = 0, cv_ = 0; \
        _Pragma("unroll") for (int j = 0; j < K; j += 8) { \
            const u64 m0_ = __ballot(key[j] >= (cand_)), m1_ = __ballot(key[j + 1] >= (cand_)), m2_ = __ballot(key[j + 2] >= (cand_)), m3_ = __ballot(key[j + 3] >= (cand_)), m4_ = __ballot(key[j + 4] >= (cand_)), m5_ = __ballot(key[j + 5] >= (cand_)); \
            cv_ += (key[j + 6] >= (cand_)) ? 1 : 0; cv_ += (key[j + 7] >= (cand_)) ? 1 : 0; \
            __builtin_amdgcn_sched_barrier(0); \
            cs_ += __popcll(m0_) + __popcll(m1_) + __popcll(m2_) + __popcll(m3_) + __popcll(m4_) + __popcll(m5_); \
            __builtin_amdgcn_sched_barrier(0); } \
        cv_ += __builtin_amdgcn_update_dpp(0, cv_, 0xB1, 0xf, 0xf, false); cv_ += __builtin_amdgcn_update_dpp(0, cv_, 0x4E, 0xf, 0xf, false); \
        cv_ += __builtin_amdgcn_update_dpp(0, cv_, 0x141, 0xf, 0xf, false); cv_ += __builtin_amdgcn_update_dpp(0, cv_, 0x140, 0xf, 0xf, false); \
        out_ = cs_ + __builtin_amdgcn_readlane(cv_, 0) + __builtin_amdgcn_readlane(cv_, 16) + __builtin_amdgcn_readlane(cv_, 32) + __builtin_amdgcn_readlane(cv_, 48); } while (0)
    unsigned Tk = 0u; int cge = 64 * K, cab = 0;
    for (int bit = 31; bit >= 16; --bit) { const unsigned cand = Tk | (1u << bit); int cnt; COUNT_GE(cand, cnt); if (cnt >= 256) { Tk = cand; cge = cnt; } else cab = cnt; }
    const int nsurv = cge - cab, needb = 256 - cab;
    int tot_ge;
    if (nsurv <= 64) {
        int ns = 0;
#pragma unroll
        for (int j = 0; j < K; ++j) ns += ((key[j] >> 16) == (Tk >> 16)) ? 1 : 0;
        int pre = ns;
#pragma unroll
        for (int m = 1; m < 64; m <<= 1) { const int o = __shfl_up(pre, m); if (lane >= m) pre += o; }
        int pos = pre - ns;
#pragma unroll
        for (int j = 0; j < K; ++j) { const bool is = (key[j] >> 16) == (Tk >> 16); sS[is ? pos : 64 + lane] = key[j]; pos += is ? 1 : 0; }
        const unsigned sk = (lane < nsurv) ? sS[lane] : 0u;
        int cgb = nsurv;
        for (int bit = 15; bit >= 0; --bit) { const unsigned cand = Tk | (1u << bit); const int cnt = __popcll(__ballot(sk >= cand)); if (cnt >= needb) { Tk = cand; cgb = cnt; } }
        tot_ge = cab + cgb;
    } else {
        for (int bit = 15; bit >= 0; --bit) { const unsigned cand = Tk | (1u << bit); int cnt; COUNT_GE(cand, cnt); if (cnt >= 256) { Tk = cand; cge = cnt; } }
        tot_ge = cge;
    }
#undef COUNT_GE
    u64 bits = 0ull;
    if (tot_ge == 256) {
        unsigned lo = 0u, hi = 0u;
#pragma unroll
        for (int j = 0; j < 32; ++j) { lo |= (key[j] >= Tk) ? (1u << j) : 0u; if (K == 64) hi |= (key[(K == 64 ? 32 : 0) + j] >= Tk) ? (1u << j) : 0u; }
        bits = (u64)lo | ((u64)hi << 32);
    } else {
        int tg = 0, ceq = 0;
#pragma unroll
        for (int j = 0; j < K; ++j) { tg += __popcll(__ballot(key[j] > Tk)); ceq += (key[j] == Tk) ? 1 : 0; if ((j & 3) == 3) __builtin_amdgcn_sched_barrier(0); }
        const int need = 256 - tg;
#pragma unroll
        for (int j = 0; j < K; ++j) asm volatile("" : "+v"(key[j]));
        int pre = ceq;
#pragma unroll
        for (int m = 1; m < 64; m <<= 1) { const int o = __shfl_up(pre, m); if (lane >= m) pre += o; }
        int run = pre - ceq;
#pragma unroll
        for (int j = 0; j < K; ++j) { const bool eq = key[j] == Tk; const bool sel = (key[j] > Tk) || (eq && run < need); run += eq ? 1 : 0; bits |= sel ? (1ull << j) : 0ull; if ((j & 3) == 3) __builtin_amdgcn_sched_barrier(0); }
    }
    return bits;
}

DI void index_item(const int tid, const int bid, unsigned char* smem, const Params& p, int b, int c, int qhalf) {
    bf16_t* sQi = (bf16_t*)smem;
    const bf16_t* U = (const bf16_t*)(p.ws + OFF_U);
    float* scr = (float*)(p.ws + OFF_R1) + (size_t)bid * (32 * 4096);
    u64* mask = (u64*)(p.ws + OFF_MASK);
    const int wid = tid >> 6, lane = tid & 63, l31 = lane & 31, hh = lane >> 5;
    const int ntile = c + 1, q0 = c * 64 + qhalf * 32; const size_t rowb = (size_t)b * S_;
    __syncthreads();
#pragma unroll
    for (int i = 0; i < 4; ++i) { const int ch = tid + i * 512, r = ch >> 6, cc = (ch & 63) * 8;
        *(u32x4*)(sQi + r * 520 + cc) = *(const u32x4*)(U + (rowb + q0 + r) * LDU + A_QI + cc); }
    float* sW = (float*)(smem + 33280);
    if (tid < 256) { const int r = tid >> 3, hd = tid & 7; sW[tid] = bf2f(U[(rowb + q0 + r) * LDU + A_WI + hd]) * (0.125f * 0.35355339059327373f); }
    __syncthreads();
    bf16x8 kfn[2][4];
    if (wid < ntile) {
#pragma unroll
        for (int mt = 0; mt < 2; ++mt)
#pragma unroll
            for (int s = 0; s < 4; ++s) kfn[mt][s] = *(const bf16x8*)(U + (rowb + wid * 64 + 32 * mt + l31) * LDU + A_KI + 16 * s + 8 * hh);
    }
    for (int kt = wid; kt < ntile; kt += 8) {
        bf16x8 kf[2][4];
#pragma unroll
        for (int mt = 0; mt < 2; ++mt)
#pragma unroll
            for (int s = 0; s < 4; ++s) kf[mt][s] = kfn[mt][s];
        if (kt + 8 < ntile) {
#pragma unroll
            for (int mt = 0; mt < 2; ++mt)
#pragma unroll
                for (int s = 0; s < 4; ++s) kfn[mt][s] = *(const bf16x8*)(U + (rowb + (kt + 8) * 64 + 32 * mt + l31) * LDU + A_KI + 16 * s + 8 * hh);
        }
        f32x16 sc[2]; sc[0] = zero16(); sc[1] = zero16();
#pragma unroll 1
        for (int hd = 0; hd < 8; ++hd) {
            bf16x8 qv[4];
#pragma unroll
            for (int s = 0; s < 4; ++s) qv[s] = *(const bf16x8*)(sQi + l31 * 520 + hd * 64 + 16 * s + 8 * hh);
            const float wv = sW[l31 * 8 + hd];
#pragma unroll
            for (int mt = 0; mt < 2; ++mt) { f32x16 rel = zero16();
#pragma unroll
                for (int s = 0; s < 4; ++s) rel = MFMA32(kf[mt][s], qv[s], rel);
#pragma unroll
                for (int r = 0; r < 16; ++r) sc[mt][r] += fmaxf(rel[r], 0.f) * wv; }
        }
#pragma unroll
        for (int mt = 0; mt < 2; ++mt)
#pragma unroll
            for (int rg = 0; rg < 4; ++rg) { f32x4 v; v[0] = sc[mt][4 * rg]; v[1] = sc[mt][4 * rg + 1]; v[2] = sc[mt][4 * rg + 2]; v[3] = sc[mt][4 * rg + 3];
                *(f32x4*)(scr + (size_t)l31 * 4096 + kt * 64 + 32 * mt + 8 * rg + 4 * hh) = v; }
    }
    __syncthreads();
    for (int qi = 0; qi < 4; ++qi) {
        const int qq = wid * 4 + qi; u64 myword = 0ull;
        unsigned* sS = (unsigned*)(smem + 36864) + wid * 128;
        if (ntile <= 4) { myword = (lane < ntile) ? ~0ull : 0ull; }
        else if (ntile <= 32) {
            const unsigned b32 = (unsigned)select_row<32>(scr + (size_t)qq * 4096, ntile * 64, sS, lane);
            const unsigned lo = (unsigned)__shfl((int)b32, (2 * lane) & 63), hi = (unsigned)__shfl((int)b32, (2 * lane + 1) & 63);
            myword = lane < 32 ? ((u64)lo | ((u64)hi << 32)) : 0ull;
        } else myword = select_row<64>(scr + (size_t)qq * 4096, ntile * 64, sS, lane);
        mask[(rowb + q0 + qq) * 64 + lane] = myword;
    }
}

DI void norm_region(bf16_t* ptr, const float* g, int lane) {
    const u32x4 w = *(const u32x4*)(ptr + lane * 8); float f[8]; unpack8(w, f); float ss = 0.f;
#pragma unroll
    for (int j = 0; j < 8; ++j) ss += f[j] * f[j];
    ss += __shfl_xor(ss, 1); ss += __shfl_xor(ss, 2); ss += __shfl_xor(ss, 4); ss += __shfl_xor(ss, 8);
    const float rs = rsqrtf(ss * (1.f / 128.f) + 1e-6f);
    const f32x4 g0 = *(const f32x4*)(g + (lane & 15) * 8), g1 = *(const f32x4*)(g + (lane & 15) * 8 + 4);
    *(bf16x8*)(ptr + lane * 8) = pack8(f[0] * rs * g0[0], f[1] * rs * g0[1], f[2] * rs * g0[2], f[3] * rs * g0[3], f[4] * rs * g1[0], f[5] * rs * g1[1], f[6] * rs * g1[2], f[7] * rs * g1[3]);
}
DI void qknorm_pass(const int tid, const int bid, const Params& p, int l) {
    const int wid = tid >> 6, lane = tid & 63, G = gridDim.x;
    bf16_t* U = (bf16_t*)(p.ws + OFF_U); bf16_t* MKV = (bf16_t*)(p.ws + OFF_MKV);
    const float* g = p.qk_g + l * 512;
    for (int row = bid * 8 + wid; row < T_ + 1024; row += G * 8) {
        if (row < T_) { bf16_t* ur = U + (size_t)row * LDU; norm_region(ur + A_Q, g, lane); norm_region(ur + A_K, g + 128, lane); norm_region(ur + M_Q, g + 256, lane); }
        else norm_region(MKV + (size_t)(row - T_) * 1024, g + 384, lane);
    }
}

constexpr int AT_SK = 0, AT_SV = 17408, AT_BUF = 18944;
template <int MODE>
DI void attn_range(const int tid, unsigned char* smem, const Params& p, int b, int hd, int q0, int kt0, int kt1, f32x16 (&ot)[4], float& lsum) {
    bf16_t* sK = (bf16_t*)(smem + AT_SK); bf16_t* sV = (bf16_t*)(smem + AT_SV);
    const bf16_t* U = (const bf16_t*)(p.ws + OFF_U); const bf16_t* MKV = (const bf16_t*)(p.ws + OFF_MKV);
    const u64* mask = (const u64*)(p.ws + OFF_MASK);
    const int wid = tid >> 6, lane = tid & 63, l31 = lane & 31, hh = lane >> 5;
    const size_t row = (size_t)b * S_ + q0 + wid * 32 + l31;
    bf16x8 qf[8];
    { const bf16_t* qp = U + row * LDU + (MODE == 0 ? M_Q : A_Q) + hd * 128 + 8 * hh;
#pragma unroll
      for (int s = 0; s < 8; ++s) qf[s] = *(const bf16x8*)(qp + 16 * s); }
    ot[0] = zero16(); ot[1] = zero16(); ot[2] = zero16(); ot[3] = zero16(); lsum = 0.f;
    const int skey = tid >> 4, spart = tid & 15;
    const bf16_t* kbase = MODE == 0 ? MKV + (size_t)(b * 256 + skey) * 1024 + hd * 128 + spart * 8 : U + ((size_t)b * S_ + skey) * LDU + A_K + hd * 128 + spart * 8;
    const size_t ldk = MODE == 0 ? 1024 : LDU, voff = MODE == 0 ? 512 : (A_V - A_K);
    u32x4 kr[2], vr[2]; u64 mwc = 0ull, mwn = 0ull;
    const int i16 = lane & 15, tq = i16 >> 2, tp = i16 & 3, tgrp = l31 >> 4;
    __syncthreads();
    { const bf16_t* kp = kbase + (size_t)kt0 * 64 * ldk;
      kr[0] = *(const u32x4*)kp; kr[1] = *(const u32x4*)(kp + 32 * ldk); vr[0] = *(const u32x4*)(kp + voff); vr[1] = *(const u32x4*)(kp + 32 * ldk + voff);
      if (MODE == 1) mwc = mask[row * 64 + kt0];
      *(u32x4*)(sK + skey * 136 + spart * 8) = kr[0]; *(u32x4*)(sK + (skey + 32) * 136 + spart * 8) = kr[1];
      *(u32x4*)(sV + skey * 160 + spart * 8) = vr[0]; *(u32x4*)(sV + (skey + 32) * 160 + spart * 8) = vr[1]; }
    if (kt0 + 1 < kt1) { const bf16_t* kp = kbase + (size_t)(kt0 + 1) * 64 * ldk;
        kr[0] = *(const u32x4*)kp; kr[1] = *(const u32x4*)(kp + 32 * ldk); vr[0] = *(const u32x4*)(kp + voff); vr[1] = *(const u32x4*)(kp + 32 * ldk + voff);
        if (MODE == 1) mwn = mask[row * 64 + kt0 + 1]; }
    __syncthreads();
    int cur = 0;
    for (int kt = kt0; kt < kt1; ++kt) {
        const bf16_t* sKc = sK + cur * AT_BUF; const bf16_t* sVc = sV + cur * AT_BUF;
        const u64 mwh = mwc >> (4 * hh);
        if (kt + 1 < kt1) { bf16_t* sKn = sK + (cur ^ 1) * AT_BUF; bf16_t* sVn = sV + (cur ^ 1) * AT_BUF;
            *(u32x4*)(sKn + skey * 136 + spart * 8) = kr[0]; *(u32x4*)(sKn + (skey + 32) * 136 + spart * 8) = kr[1];
            *(u32x4*)(sVn + skey * 160 + spart * 8) = vr[0]; *(u32x4*)(sVn + (skey + 32) * 160 + spart * 8) = vr[1];
            mwc = mwn; }
        if (kt + 2 < kt1) { const bf16_t* kp = kbase + (size_t)(kt + 2) * 64 * ldk;
            kr[0] = *(const u32x4*)kp; kr[1] = *(const u32x4*)(kp + 32 * ldk); vr[0] = *(const u32x4*)(kp + voff); vr[1] = *(const u32x4*)(kp + 32 * ldk + voff);
            if (MODE == 1) mwn = mask[row * 64 + kt + 2]; }
        f32x16 st[2]; st[0] = zero16(); st[1] = zero16();
#pragma unroll
        for (int mt = 0; mt < 2; ++mt)
#pragma unroll
            for (int s = 0; s < 8; ++s) { const bf16x8 kf = *(const bf16x8*)(sKc + (32 * mt + l31) * 136 + 16 * s + 8 * hh); st[mt] = MFMA32(kf, qf[s], st[mt]); }
        bf16x8 pb[2][2];
#pragma unroll
        for (int mt = 0; mt < 2; ++mt) {
            const int mw32 = (int)(unsigned)(mwh >> (32 * mt));
#pragma unroll
            for (int r = 0; r < 16; ++r) { float pv = __builtin_amdgcn_exp2f(st[mt][r] * (0.08838834764831845f * 1.4426950408889634f));
                if (MODE == 1) pv = __int_as_float(__float_as_int(pv) & __builtin_amdgcn_sbfe(mw32, (r & 3) + 8 * (r >> 2), 1));
                lsum += pv; st[mt][r] = pv; }
            pb[mt][0] = pack8(st[mt][0], st[mt][1], st[mt][2], st[mt][3], st[mt][4], st[mt][5], st[mt][6], st[mt][7]);
            pb[mt][1] = pack8(st[mt][8], st[mt][9], st[mt][10], st[mt][11], st[mt][12], st[mt][13], st[mt][14], st[mt][15]);
        }
#pragma unroll
        for (int i = 0; i < 4; ++i)
#pragma unroll
            for (int mt = 0; mt < 2; ++mt)
#pragma unroll
                for (int s2 = 0; s2 < 2; ++s2) { const bf16_t* vp = sVc + (32 * mt + 16 * s2 + 4 * hh + tq) * 160 + 32 * i + 16 * tgrp + 4 * tp;
                    const s16x4 lo = __builtin_amdgcn_ds_read_tr16_b64_v4i16((LAS s16x4*)vp), hi = __builtin_amdgcn_ds_read_tr16_b64_v4i16((LAS s16x4*)(vp + 8 * 160));
                    ot[i] = MFMA32(__builtin_shufflevector(lo, hi, 0, 1, 2, 3, 4, 5, 6, 7), pb[mt][s2], ot[i]); }
        __syncthreads();
        cur ^= 1;
    }
    lsum += __shfl_xor(lsum, 32);
}

DI void attnM_item(const int tid, unsigned char* smem, const Params& p, int item) {
    const bf16_t* U = (const bf16_t*)(p.ws + OFF_U); bf16_t* Y = (bf16_t*)(p.ws + OFF_Y);
    const int wid = tid >> 6, lane = tid & 63, l31 = lane & 31, hh = lane >> 5;
    const int b = item >> 6, qt = (item >> 2) & 15, hd = item & 3, q0 = qt * 256;
    f32x16 ot[4]; float lsum;
    attn_range<0>(tid, smem, p, b, hd, q0, 0, 4, ot, lsum);
    const size_t row = (size_t)b * S_ + q0 + wid * 32 + l31; const float inv = 1.0f / lsum;
#pragma unroll
    for (int i = 0; i < 4; ++i)
#pragma unroll
        for (int rg = 0; rg < 4; ++rg) { const int col = hd * 128 + 32 * i + 8 * rg + 4 * hh;
            const u32x2 zw = *(const u32x2*)(U + row * LDU + M_Z + col);
            u32x2 w; w.x = pk2(ot[i][4 * rg] * inv * siluf_(lo16(zw.x)), ot[i][4 * rg + 1] * inv * siluf_(hi16(zw.x)));
            w.y = pk2(ot[i][4 * rg + 2] * inv * siluf_(lo16(zw.y)), ot[i][4 * rg + 3] * inv * siluf_(hi16(zw.y)));
            *(u32x2*)(Y + row * 2048 + 3 * 512 + col) = w; }
}
DI void attnA_item(const int tid, unsigned char* smem, const Params& p, int item) {
    float* Opart = (float*)(p.ws + OFF_R1); float* lpart = Opart + (size_t)2 * T_ * 512;
    const int wid = tid >> 6, lane = tid & 63, l31 = lane & 31, hh = lane >> 5;
    const int b = item >> 6, hd = (item >> 4) & 3, pr = (item >> 1) & 7, half = item & 1;
#pragma unroll 1
    for (int sub = 0; sub < 2; ++sub) {
        const int qt = sub == 0 ? pr : 15 - pr, n2 = 2 * (qt + 1), q0 = qt * 256;
        f32x16 ot[4]; float lsum;
        attn_range<1>(tid, smem, p, b, hd, q0, half * n2, (half + 1) * n2, ot, lsum);
        const size_t row = (size_t)b * S_ + q0 + wid * 32 + l31;
        float* op = Opart + ((size_t)half * T_ + row) * 512 + hd * 128;
#pragma unroll
        for (int i = 0; i < 4; ++i)
#pragma unroll
            for (int rg = 0; rg < 4; ++rg) { f32x4 v; v[0] = ot[i][4 * rg]; v[1] = ot[i][4 * rg + 1]; v[2] = ot[i][4 * rg + 2]; v[3] = ot[i][4 * rg + 3];
                *(f32x4*)(op + 32 * i + 8 * rg + 4 * hh) = v; }
        if (hh == 0) lpart[((size_t)half * T_ + row) * 4 + hd] = lsum;
    }
}
DI void attnA_finalize(const int tid, const int bid, const Params& p) {
    const float* Opart = (const float*)(p.ws + OFF_R1); const float* lpart = Opart + (size_t)2 * T_ * 512;
    const bf16_t* U = (const bf16_t*)(p.ws + OFF_U); bf16_t* Y = (bf16_t*)(p.ws + OFF_Y);
    for (int i = bid * 512 + tid; i < T_ * 128; i += gridDim.x * 512) { const int row = i >> 7, c4 = (i & 127) * 4, hd = c4 >> 7;
        const f32x4 o0 = *(const f32x4*)(Opart + (size_t)row * 512 + c4), o1 = *(const f32x4*)(Opart + ((size_t)T_ + row) * 512 + c4);
        const float inv = 1.0f / (lpart[(size_t)row * 4 + hd] + lpart[((size_t)T_ + row) * 4 + hd]);
        const u32x2 zw = *(const u32x2*)(U + (size_t)row * LDU + A_Z + c4);
        u32x2 w; w.x = pk2((o0[0] + o1[0]) * inv * siluf_(lo16(zw.x)), (o0[1] + o1[1]) * inv * siluf_(hi16(zw.x)));
        w.y = pk2((o0[2] + o1[2]) * inv * siluf_(lo16(zw.y)), (o0[3] + o1[3]) * inv * siluf_(hi16(zw.y)));
        *(u32x2*)(Y + (size_t)row * 2048 + c4) = w; }
}

constexpr int CK_SQ = 0, CK_SK = 17408, CK_SQD = 34816, CK_SVT = 52224, CK_SKDT = 70656, CK_CUM = 89088, CK_TOT = 122112, CK_RED = 124160;
DI float lgamma_h(int hd) { return hd == 0 ? -0.031748698314580301f : hd == 1 ? -0.015748356968139168f : hd == 2 ? -0.0078431774610258928f : -0.0039138993211363287f; }

template <int PH>
DI void chunk_item(const int tid, unsigned char* smem, const Params& p, int l, int item) {
    bf16_t* sQ = (bf16_t*)(smem + CK_SQ); bf16_t* sK = (bf16_t*)(smem + CK_SK); bf16_t* sQd = (bf16_t*)(smem + CK_SQD);
    bf16_t* sVt = (bf16_t*)(smem + CK_SVT); bf16_t* sKdT = (bf16_t*)(smem + CK_SKDT);
    float* sCum = (float*)(smem + CK_CUM); float* sTot = (float*)(smem + CK_TOT); float* sRed = (float*)(smem + CK_RED);
    const bf16_t* U = (const bf16_t*)(p.ws + OFF_U); bf16_t* Y = (bf16_t*)(p.ws + OFF_Y);
    const int wid = tid >> 6, lane = tid & 63, l31 = lane & 31, hh = lane >> 5;
    const int mode = item >> 10, rem = item & 1023, b = rem >> 8, hd = (rem >> 6) & 3, n = rem & 63;
    bf16_t* ST = (bf16_t*)(p.ws + (mode == 0 ? OFF_STB : OFF_STC)) + (size_t)rem * 16384;
    const float lg = lgamma_h(hd);
    __syncthreads();
    {
        const int s = tid & 63, wd = tid >> 6; const size_t row = (size_t)b * S_ + n * 64 + s;
        const bf16_t* ur = U + row * LDU;
        if (mode == 0) {
            const int pos = n * 64 + s; const float* rope = (const float*)(p.ws + OFF_ROPE);
            float cs[8], sn[8];
            { const f32x4 c0 = *(const f32x4*)(rope + pos * 64 + wd * 8), c1 = *(const f32x4*)(rope + pos * 64 + wd * 8 + 4);
              const f32x4 s0 = *(const f32x4*)(rope + 4096 * 64 + pos * 64 + wd * 8), s1 = *(const f32x4*)(rope + 4096 * 64 + pos * 64 + wd * 8 + 4);
#pragma unroll
              for (int e = 0; e < 4; ++e) { cs[e] = c0[e]; cs[4 + e] = c1[e]; sn[e] = s0[e]; sn[4 + e] = s1[e]; } }
            float k1[8], k2[8], ka[8], kb[8];
            unpack8(*(const u32x4*)(ur + B_K + hd * 128 + wd * 8), k1); unpack8(*(const u32x4*)(ur + B_K + hd * 128 + 64 + wd * 8), k2);
#pragma unroll
            for (int e = 0; e < 8; ++e) { ka[e] = (k1[e] * cs[e] - k2[e] * sn[e]) * 0.08838834764831845f; kb[e] = (k1[e] * sn[e] + k2[e] * cs[e]) * 0.08838834764831845f; }
            if (PH == 4) {
                float q1[8], q2[8], qa[8], qb[8];
                unpack8(*(const u32x4*)(ur + B_Q + hd * 128 + wd * 8), q1); unpack8(*(const u32x4*)(ur + B_Q + hd * 128 + 64 + wd * 8), q2);
#pragma unroll
                for (int e = 0; e < 8; ++e) { qa[e] = q1[e] * cs[e] - q2[e] * sn[e]; qb[e] = q1[e] * sn[e] + q2[e] * cs[e]; }
                *(bf16x8*)(sQ + s * 136 + wd * 8) = pack8(qa[0], qa[1], qa[2], qa[3], qa[4], qa[5], qa[6], qa[7]);
                *(bf16x8*)(sQ + s * 136 + 64 + wd * 8) = pack8(qb[0], qb[1], qb[2], qb[3], qb[4], qb[5], qb[6], qb[7]);
                const float gqd = __expf(lg * (float)(s + 1));
                *(bf16x8*)(sQd + s * 136 + wd * 8) = pack8(qa[0] * gqd, qa[1] * gqd, qa[2] * gqd, qa[3] * gqd, qa[4] * gqd, qa[5] * gqd, qa[6] * gqd, qa[7] * gqd);
                *(bf16x8*)(sQd + s * 136 + 64 + wd * 8) = pack8(qb[0] * gqd, qb[1] * gqd, qb[2] * gqd, qb[3] * gqd, qb[4] * gqd, qb[5] * gqd, qb[6] * gqd, qb[7] * gqd);
                *(bf16x8*)(sK + s * 136 + wd * 8) = pack8(ka[0], ka[1], ka[2], ka[3], ka[4], ka[5], ka[6], ka[7]);
                *(bf16x8*)(sK + s * 136 + 64 + wd * 8) = pack8(kb[0], kb[1], kb[2], kb[3], kb[4], kb[5], kb[6], kb[7]);
            } else {
                const float gkd = __expf(lg * (float)(63 - s));
#pragma unroll
                for (int e = 0; e < 8; ++e) { sKdT[(wd * 8 + e) * 72 + s] = f2bf(ka[e] * gkd); sKdT[(64 + wd * 8 + e) * 72 + s] = f2bf(kb[e] * gkd); }
            }
            const u32x4 v0 = *(const u32x4*)(ur + B_V + hd * 128 + wd * 16), v1 = *(const u32x4*)(ur + B_V + hd * 128 + wd * 16 + 8);
            const unsigned w[8] = {v0.x, v0.y, v0.z, v0.w, v1.x, v1.y, v1.z, v1.w};
#pragma unroll
            for (int e = 0; e < 8; ++e) { sVt[(wd * 16 + 2 * e) * 72 + s] = (bf16_t)(w[e] & 0xffffu); sVt[(wd * 16 + 2 * e + 1) * 72 + s] = (bf16_t)(w[e] >> 16); }
        } else {
            const int d0 = wd * 16;
            float cf[16], kfv[16];
            unpack8(*(const u32x4*)(ur + C_F + hd * 128 + d0), cf); unpack8(*(const u32x4*)(ur + C_F + hd * 128 + d0 + 8), cf + 8);
#pragma unroll
            for (int e = 0; e < 16; ++e) {
                float lb = 0.f;
                if (l == 1) lb = sigmoidf_(p.lb_logits[512 + hd * 128 + d0 + e] - p.lb_logits[hd * 128 + d0 + e]);
                const float sg = sigmoidf_(cf[e]); const float f = lb + (1.f - lb) * sg;
                kfv[e] = (1.f - lb) * (1.f - sg);
                sCum[s * 129 + d0 + e] = fmaxf(__logf(f), -30.f);
            }
            __syncthreads();
            { const int seg = tid >> 7, d = tid & 127; float run = 0.f;
#pragma unroll
              for (int i = 0; i < 16; ++i) { const int ix = (seg * 16 + i) * 129 + d; run += sCum[ix]; sCum[ix] = run; }
              sTot[seg * 128 + d] = run; }
            __syncthreads();
            { const int seg = tid >> 7, d = tid & 127; float off = 0.f;
              for (int g = 0; g < seg; ++g) off += sTot[g * 128 + d];
              if (seg > 0) {
#pragma unroll
                  for (int i = 0; i < 16; ++i) sCum[(seg * 16 + i) * 129 + d] += off; } }
            __syncthreads();
            if (PH == 4) {
                float q[16];
                unpack8(*(const u32x4*)(ur + C_Q + hd * 128 + d0), q); unpack8(*(const u32x4*)(ur + C_Q + hd * 128 + d0 + 8), q + 8);
                float a[16], kk[16], qd[16];
#pragma unroll
                for (int e = 0; e < 16; ++e) { const float cum = sCum[s * 129 + d0 + e], ref = sCum[31 * 129 + d0 + e];
                    const float dl = fminf(fmaxf(cum - ref, -80.f), 80.f);
                    a[e] = q[e] * __expf(dl); kk[e] = kfv[e] * __expf(-dl); qd[e] = q[e] * __expf(cum); }
                *(bf16x8*)(sQ + s * 136 + d0) = pack8(a[0], a[1], a[2], a[3], a[4], a[5], a[6], a[7]);
                *(bf16x8*)(sQ + s * 136 + d0 + 8) = pack8(a[8], a[9], a[10], a[11], a[12], a[13], a[14], a[15]);
                *(bf16x8*)(sK + s * 136 + d0) = pack8(kk[0], kk[1], kk[2], kk[3], kk[4], kk[5], kk[6], kk[7]);
                *(bf16x8*)(sK + s * 136 + d0 + 8) = pack8(kk[8], kk[9], kk[10], kk[11], kk[12], kk[13], kk[14], kk[15]);
                *(bf16x8*)(sQd + s * 136 + d0) = pack8(qd[0], qd[1], qd[2], qd[3], qd[4], qd[5], qd[6], qd[7]);
                *(bf16x8*)(sQd + s * 136 + d0 + 8) = pack8(qd[8], qd[9], qd[10], qd[11], qd[12], qd[13], qd[14], qd[15]);
            } else {
#pragma unroll
                for (int e = 0; e < 16; ++e) { const float cum = sCum[s * 129 + d0 + e], en = sCum[63 * 129 + d0 + e];
                    sKdT[(d0 + e) * 72 + s] = f2bf(kfv[e] * __expf(en - cum)); }
                if (tid < 128) ((float*)(p.ws + OFF_DEC))[rem * 128 + tid] = __expf(sCum[63 * 129 + tid]);
            }
            const u32x4 v0 = *(const u32x4*)(ur + C_I + hd * 128 + d0), v1 = *(const u32x4*)(ur + C_I + hd * 128 + d0 + 8);
            const unsigned w[8] = {v0.x, v0.y, v0.z, v0.w, v1.x, v1.y, v1.z, v1.w};
#pragma unroll
            for (int e = 0; e < 8; ++e) { sVt[(d0 + 2 * e) * 72 + s] = (bf16_t)(w[e] & 0xffffu); sVt[(d0 + 2 * e + 1) * 72 + s] = (bf16_t)(w[e] >> 16); }
        }
    }
    __syncthreads();
    if (PH == 2) {
        const int vt = wid >> 1, dtb = (wid & 1) * 2;
        f32x16 acc[2]; acc[0] = zero16(); acc[1] = zero16();
#pragma unroll
        for (int s2 = 0; s2 < 4; ++s2) { const bf16x8 af = *(const bf16x8*)(sVt + (32 * vt + l31) * 72 + 16 * s2 + 8 * hh);
#pragma unroll
            for (int j = 0; j < 2; ++j) { const bf16x8 bfr = *(const bf16x8*)(sKdT + (32 * (dtb + j) + l31) * 72 + 16 * s2 + 8 * hh); acc[j] = MFMA32(af, bfr, acc[j]); } }
#pragma unroll
        for (int j = 0; j < 2; ++j)
#pragma unroll
            for (int r = 0; r < 16; ++r) { const int v = 32 * vt + (r & 3) + 8 * (r >> 2) + 4 * hh; ST[v * 128 + 32 * (dtb + j) + l31] = f2bf(acc[j][r]); }
    } else {
        const int tg = wid & 1, vt = wid >> 1, t_idx = 32 * tg + l31;
        f32x16 st[2]; st[0] = zero16(); st[1] = zero16();
#pragma unroll
        for (int s = 0; s < 8; ++s) { const bf16x8 qf = *(const bf16x8*)(sQ + t_idx * 136 + 16 * s + 8 * hh);
#pragma unroll
            for (int mt = 0; mt < 2; ++mt) { const bf16x8 kf = *(const bf16x8*)(sK + (32 * mt + l31) * 136 + 16 * s + 8 * hh); st[mt] = MFMA32(kf, qf, st[mt]); } }
        bf16x8 pb[2][2];
#pragma unroll
        for (int mt = 0; mt < 2; ++mt) {
#pragma unroll
            for (int r = 0; r < 16; ++r) { const int s_idx = 32 * mt + (r & 3) + 8 * (r >> 2) + 4 * hh;
                if (mode == 0) st[mt][r] *= __expf(lg * fabsf((float)(t_idx - s_idx)));
                else st[mt][r] = (s_idx <= t_idx) ? st[mt][r] : 0.f; }
            pb[mt][0] = pack8(st[mt][0], st[mt][1], st[mt][2], st[mt][3], st[mt][4], st[mt][5], st[mt][6], st[mt][7]);
            pb[mt][1] = pack8(st[mt][8], st[mt][9], st[mt][10], st[mt][11], st[mt][12], st[mt][13], st[mt][14], st[mt][15]);
        }
        f32x16 o = zero16();
#pragma unroll
        for (int mt = 0; mt < 2; ++mt)
#pragma unroll
            for (int s2 = 0; s2 < 2; ++s2) { const bf16_t* vr = sVt + (32 * vt + l31) * 72 + 32 * mt + 16 * s2 + 4 * hh;
                const s16x4 lo = *(const s16x4*)vr, hi = *(const s16x4*)(vr + 8);
                o = MFMA32(__builtin_shufflevector(lo, hi, 0, 1, 2, 3, 4, 5, 6, 7), pb[mt][s2], o); }
#pragma unroll
        for (int s = 0; s < 8; ++s) { const bf16x8 af = *(const bf16x8*)(ST + (32 * vt + l31) * 128 + 16 * s + 8 * hh);
            const bf16x8 bq = *(const bf16x8*)(sQd + t_idx * 136 + 16 * s + 8 * hh);
            o = MFMA32(af, bq, o); }
        float ss = 0.f;
#pragma unroll
        for (int r = 0; r < 16; ++r) ss += o[r] * o[r];
        ss += __shfl_xor(ss, 32);
        if (hh == 0) sRed[vt * 64 + t_idx] = ss;
        __syncthreads();
        const float tot = sRed[t_idx] + sRed[64 + t_idx] + sRed[128 + t_idx] + sRed[192 + t_idx];
        const float rstd = rsqrtf(tot * (1.f / 128.f) + 1e-6f);
        const float* gain = (mode == 0 ? p.ret_g : p.hgrn_g) + (l * 4 + hd) * 128;
        const int zoff = mode == 0 ? B_Z : C_Z, brn = mode == 0 ? 1 : 2;
        const size_t row = (size_t)b * S_ + n * 64 + t_idx;
#pragma unroll
        for (int rg = 0; rg < 4; ++rg) { const int v = 32 * vt + 8 * rg + 4 * hh; const f32x4 gg = *(const f32x4*)(gain + v);
            const u32x2 zw = *(const u32x2*)(U + row * LDU + zoff + hd * 128 + v);
            u32x2 w; w.x = pk2(o[4 * rg] * rstd * gg[0] * siluf_(lo16(zw.x)), o[4 * rg + 1] * rstd * gg[1] * siluf_(hi16(zw.x)));
            w.y = pk2(o[4 * rg + 2] * rstd * gg[2] * siluf_(lo16(zw.y)), o[4 * rg + 3] * rstd * gg[3] * siluf_(hi16(zw.y)));
            *(u32x2*)(Y + row * 2048 + brn * 512 + hd * 128 + v) = w; }
    }
}

DI void scan_item(const int tid, const Params& p, int item) {
    const int mode = item >> 7, rem = item & 127, bh = rem >> 3, slice = rem & 7, hd = bh & 3;
    const int e0 = slice * 2048 + tid * 4, d = e0 & 127;
    bf16_t* ST = (bf16_t*)(p.ws + (mode == 0 ? OFF_STB : OFF_STC)) + (size_t)bh * 64 * 16384 + e0;
    const float* DEC = (const float*)(p.ws + OFF_DEC) + (size_t)bh * 64 * 128 + d;
    const float gdec = __expf(lgamma_h(hd) * 64.f);
    f32x4 prev = (f32x4){0.f, 0.f, 0.f, 0.f};
    for (int n0 = 0; n0 < 64; n0 += 8) {
        u32x2 cur[8]; f32x4 dec[8];
#pragma unroll
        for (int i = 0; i < 8; ++i) { cur[i] = *(const u32x2*)(ST + (size_t)(n0 + i) * 16384);
            dec[i] = mode == 0 ? (f32x4){gdec, gdec, gdec, gdec} : *(const f32x4*)(DEC + (n0 + i) * 128); }
#pragma unroll
        for (int i = 0; i < 8; ++i) { u32x2 w; w.x = pk2(prev[0], prev[1]); w.y = pk2(prev[2], prev[3]); *(u32x2*)(ST + (size_t)(n0 + i) * 16384) = w;
            const f32x4 c = {lo16(cur[i].x), hi16(cur[i].x), lo16(cur[i].y), hi16(cur[i].y)}; prev = dec[i] * prev + c; }
    }
}

#define XB_TMO      128
#define XB_XCNT(j)  (256  + 64 * (j))
#define XB_XSUB(j)  (1280 + 64 * (j))
#define XB_XGEN(j)  (2304 + 64 * (j))
#define XB_TOP      3328
#define XB_TOPGEN   3392
#define XB_SPIN_CAP (1u << 18)
DI unsigned xb_ld(unsigned* p) { return __hip_atomic_load(p, __ATOMIC_RELAXED, __HIP_MEMORY_SCOPE_AGENT); }
DI unsigned xb_add(unsigned* p, unsigned v) { return __hip_atomic_fetch_add(p, v, __ATOMIC_RELAXED, __HIP_MEMORY_SCOPE_AGENT); }
DI unsigned xb_xcc_id() { return (unsigned)__builtin_amdgcn_s_getreg((3 << 11) | 20) & 0xFu; }
#define XB_SPIN(cond, bar) do { unsigned _sp = 0; while (cond) { __builtin_amdgcn_s_sleep(1); \
    if ((++_sp & 255u) == 0u) { if (xb_ld(&(bar)[XB_TMO])) break; if (_sp > XB_SPIN_CAP) { atomicAdd(&(bar)[XB_TMO], 1u); break; } } } } while (0)
struct XcdBarrier { unsigned* bar; unsigned x; volatile LAS unsigned* st; };
DI XcdBarrier xcd_barrier_post(unsigned* bar, volatile LAS unsigned* st) {
    XcdBarrier b; b.bar = bar; b.x = xb_xcc_id(); b.st = st;
    if (threadIdx.x == 0) (void)xb_add(&bar[XB_XCNT(b.x)], 1u);
    return b;
}
DI void xcd_barrier_complete(unsigned* bar, unsigned x, unsigned& nloc, unsigned& nx) {
    const unsigned G = gridDim.x * gridDim.y * gridDim.z;
    unsigned sum, cnt, mine, sp = 0u;
    for (;;) {
        sum = 0u; cnt = 0u; mine = 0u;
#pragma unroll
        for (unsigned j = 0; j < 16; ++j) { const unsigned c = xb_ld(&bar[XB_XCNT(j)]); sum += c; cnt += (c > 0u) ? 1u : 0u; mine = (j == x) ? c : mine; }
        if (sum == G) break;
        __builtin_amdgcn_s_sleep(1);
        if ((++sp & 255u) == 0u) { if (xb_ld(&bar[XB_TMO])) break; if (sp > XB_SPIN_CAP) { atomicAdd(&bar[XB_TMO], 1u); break; } }
    }
    nloc = mine > 0u ? mine : 1u; nx = cnt > 0u ? cnt : 1u;
}
DI void xcd_barrier(const XcdBarrier& b) {
    asm volatile("s_waitcnt vmcnt(0)" ::: "memory");
    __syncthreads();
    if (threadIdx.x == 0) {
        unsigned* bar = b.bar;
        __builtin_amdgcn_s_waitcnt(0);
        unsigned nloc = b.st[0], nx = b.st[1];
        if (nloc == 0u) { xcd_barrier_complete(bar, b.x, nloc, nx); b.st[0] = nloc; b.st[1] = nx; }
        const unsigned old = xb_add(&bar[XB_XSUB(b.x)], 1u);
        const unsigned gen = old / nloc;
        if (old + 1u == (gen + 1u) * nloc) {
            __builtin_amdgcn_fence(__ATOMIC_RELEASE, "agent");
            asm volatile("s_waitcnt vmcnt(0)" ::: "memory");
            const unsigned og = xb_add(&bar[XB_TOP], 1u);
            const unsigned tg = og / nx;
            if (og + 1u == (tg + 1u) * nx) xb_add(&bar[XB_TOPGEN], 1u);
            else XB_SPIN(xb_ld(&bar[XB_TOPGEN]) == tg, bar);
            __builtin_amdgcn_fence(__ATOMIC_ACQUIRE, "agent");
            xb_add(&bar[XB_XGEN(b.x)], 1u);
            asm volatile("s_waitcnt vmcnt(0)" ::: "memory");
        } else {
            XB_SPIN(xb_ld(&bar[XB_XGEN(b.x)]) == gen, bar);
            __builtin_amdgcn_fence(__ATOMIC_ACQUIRE, "agent");
            asm volatile("s_waitcnt vmcnt(0)" ::: "memory");
        }
    }
    __syncthreads();
}

#define OPQ() do { asm volatile("" : "+v"(tid)); asm volatile("" : "+s"(bid)); } while (0)
template <int Q>
DI void run_phase(const int l, int tid, int bid, unsigned char* smem, const Params& p) {
    const int G = gridDim.x;
    OPQ();
    if (Q == 0) {
        phase_prep(tid, bid, smem, p, l);
    } else if (Q == 1) {
        { pg8::Gemm g{(const bf16_t*)(p.ws + OFF_H), (const bf16_t*)(p.ws + OFF_WINT), 2048, 2048, T_, G_OFF, 2048};
          pg8::StaticOrder S; S.init(g.M, g.N, G, bid);
          pg8::EpiBf16 E{(bf16_t*)(p.ws + OFF_U), LDU, 1 << 30};
          pg8::gemm_phase(tid, ((LAS unsigned char*)smem), g, S, E); }
        OPQ();
        { pg8::Gemm g{(const bf16_t*)(p.ws + OFF_H), (const bf16_t*)(p.ws + OFF_WINT) + (size_t)G_OFF * 2048, 2048, 2048, T_, 8192, 2048};
          pg8::StaticOrder S; S.init(g.M, g.N, G, bid);
          pg8::EpiGateRatio E{(bf16_t*)(p.ws + OFF_U)};
          pg8::gemm_phase(tid, ((LAS unsigned char*)smem), g, S, E); }
        OPQ();
        { pg8::Gemm g{(const bf16_t*)(p.ws + OFF_MEMB), (const bf16_t*)(p.ws + OFF_WMKV), 2048, 2048, 1024, 1024, 2048};
          pg8::StaticOrder S; S.init(g.M, g.N, G, (bid + G - (3 * G) / 4) % G);
          pg8::EpiBf16 E{(bf16_t*)(p.ws + OFF_MKV), 1024, 1 << 30};
          pg8::gemm_phase(tid, ((LAS unsigned char*)smem), g, S, E); }
    } else if (Q == 2) {
        for (int j = bid; j < 256; j += G) { const int b = j >> 6, c = j & 63; index_item(tid, bid, smem, p, b, c, 0); index_item(tid, bid, smem, p, b, 63 - c, 1); }
        OPQ(); qknorm_pass(tid, bid, p, l);
        OPQ(); for (int j = bid; j < 2048; j += G) chunk_item<2>(tid, smem, p, l, j);
    } else if (Q == 3) {
        for (int j = bid; j < 256; j += G) attnA_item(tid, smem, p, (G == 256) ? ((((j & 7) * 2 + ((j >> 3) >> 4)) << 4) | ((j >> 3) & 15)) : j);
        OPQ(); for (int j = bid; j < 256; j += G) attnM_item(tid, smem, p, j);
        OPQ(); for (int j = bid; j < 256; j += G) scan_item(tid, p, j);
    } else if (Q == 4) {
        for (int j = bid; j < 2048; j += G) chunk_item<4>(tid, smem, p, l, j);
        OPQ(); attnA_finalize(tid, bid, p);
    } else if (Q == 5) {
        pg8::Gemm g{(const bf16_t*)(p.ws + OFF_Y), (const bf16_t*)(p.ws + OFF_WBRT), 2048, 2048, T_, 2048, 2048};
        pg8::StaticOrder S; S.init(g.M, g.N, G, bid);
        pg8::EpiMerged E{(bf16_t*)(p.ws + OFF_H), (const bf16_t*)(p.ws + OFF_U)};
        pg8::HookGate HK{(const bf16_t*)(p.ws + OFF_U)};
        pg8::gemm_phase(tid, ((LAS unsigned char*)smem), g, S, E, HK);
    } else {
        pg8::Gemm g{(const bf16_t*)(p.ws + OFF_H), (const bf16_t*)(p.ws + OFF_WOUT), 2048, 2048, T_, 2048, 2048};
        pg8::StaticOrder S; S.init(g.M, g.N, G, bid);
        pg8::EpiOut E{l == 0 ? p.x : p.out, p.out};
        pg8::gemm_phase(tid, ((LAS unsigned char*)smem), g, S, E);
    }
}

template <int Q>
__global__ __launch_bounds__(512, 2) void mega_one(Params p, int l) {
    extern __shared__ __attribute__((aligned(16))) unsigned char smem[];
    run_phase<Q>(l, threadIdx.x, blockIdx.x, smem, p);
}

#ifndef DUPMASK
#define DUPMASK 0
#endif
#define GSYNC() xcd_barrier(xb)
#define RUNP(Q) do { run_phase<Q>(L, threadIdx.x, blockIdx.x, smem, p); if ((DUPMASK >> Q) & 1) { GSYNC(); run_phase<Q>(L, threadIdx.x, blockIdx.x, smem, p); } } while (0)
template <int L>
DI void run_layer(unsigned char* smem, const Params& p, const XcdBarrier& xb) {
    RUNP(0); GSYNC();
    RUNP(1); GSYNC();
    RUNP(2); GSYNC();
    RUNP(3); GSYNC();
    RUNP(4); GSYNC();
    RUNP(5); GSYNC();
    RUNP(6);
}
__global__ __launch_bounds__(512, 2) void mega_all(Params p) {
    extern __shared__ __attribute__((aligned(16))) unsigned char smem[];
    volatile LAS unsigned* st = (volatile LAS unsigned*)((LAS unsigned char*)smem + 131072);
    if (threadIdx.x == 0) { st[0] = 0u; st[1] = 0u; st[2] = 0u; st[3] = 0u; }
    __syncthreads();
    const XcdBarrier xb = xcd_barrier_post((unsigned*)(p.ws + OFF_BAR), st);
    run_layer<0>(smem, p, xb);
    GSYNC();
    if (p.coop == 0x7fffffff) cg::this_grid().sync();
    run_layer<1>(smem, p, xb);
}

extern "C" void kernel_launch(void* const* d_in, const int* in_sizes, int n_in, void* d_out, int out_size, void* d_ws, size_t ws_size, hipStream_t stream) {
    static int grid = 0;
    if (grid == 0) {
        if (n_in != 11 || ws_size < WS_NEED || out_size != T_ * 2048) { fprintf(stderr, "kernel_launch: unexpected sizes n_in=%d ws=%zu need=%zu out=%d\n", n_in, ws_size, (size_t)WS_NEED, out_size); grid = -1; return; }
        int dev = 0, cus = 0, per_cu = 0;
        (void)hipGetDevice(&dev); (void)hipDeviceGetAttribute(&cus, hipDeviceAttributeMultiprocessorCount, dev);
#if MULTI_LAUNCH
        (void)hipFuncSetAttribute((const void*)mega_one<0>, hipFuncAttributeMaxDynamicSharedMemorySize, LDS_BYTES); (void)hipFuncSetAttribute((const void*)mega_one<1>, hipFuncAttributeMaxDynamicSharedMemorySize, LDS_BYTES);
        (void)hipFuncSetAttribute((const void*)mega_one<2>, hipFuncAttributeMaxDynamicSharedMemorySize, LDS_BYTES); (void)hipFuncSetAttribute((const void*)mega_one<3>, hipFuncAttributeMaxDynamicSharedMemorySize, LDS_BYTES);
        (void)hipFuncSetAttribute((const void*)mega_one<4>, hipFuncAttributeMaxDynamicSharedMemorySize, LDS_BYTES); (void)hipFuncSetAttribute((const void*)mega_one<5>, hipFuncAttributeMaxDynamicSharedMemorySize, LDS_BYTES);
        (void)hipFuncSetAttribute((const void*)mega_one<6>, hipFuncAttributeMaxDynamicSharedMemorySize, LDS_BYTES);
#else
        if (hipFuncSetAttribute((const void*)mega_all, hipFuncAttributeMaxDynamicSharedMemorySize, LDS_BYTES) != hipSuccess) { fprintf(stderr, "kernel_launch: hipFuncSetAttribute failed\n"); grid = -1; return; }
        (void)hipOccupancyMaxActiveBlocksPerMultiprocessor(&per_cu, (const void*)mega_all, 512, LDS_BYTES);
        if (per_cu < 1) { fprintf(stderr, "kernel_launch: occupancy query says %d blocks per CU\n", per_cu); per_cu = 1; }
#endif
        (void)hipGetLastError();
        grid = cus < 256 ? cus : 256;
    }
    if (grid < 0) return;
    Params p{};
    p.x = (const float*)d_in[0]; p.mem = (const float*)d_in[1]; p.norm_g = (const float*)d_in[2]; p.w_in = (const float*)d_in[3]; p.qk_g = (const float*)d_in[4];
    p.ret_g = (const float*)d_in[5]; p.hgrn_g = (const float*)d_in[6]; p.lb_logits = (const float*)d_in[7]; p.w_mem_kv = (const float*)d_in[8]; p.w_branch = (const float*)d_in[9]; p.w_out = (const float*)d_in[10];
    p.out = (float*)d_out; p.ws = (unsigned char*)d_ws; p.pad = 0;
#if MULTI_LAUNCH
    for (int ph = 0; ph < NPH; ++ph) { const int l = ph / 7;
        switch (ph % 7) {
            case 0: hipLaunchKernelGGL(mega_one<0>, dim3(grid), dim3(512), LDS_BYTES, stream, p, l); break;
            case 1: hipLaunchKernelGGL(mega_one<1>, dim3(grid), dim3(512), LDS_BYTES, stream, p, l); break;
            case 2: hipLaunchKernelGGL(mega_one<2>, dim3(grid), dim3(512), LDS_BYTES, stream, p, l); break;
            case 3: hipLaunchKernelGGL(mega_one<3>, dim3(grid), dim3(512), LDS_BYTES, stream, p, l); break;
            case 4: hipLaunchKernelGGL(mega_one<4>, dim3(grid), dim3(512), LDS_BYTES, stream, p, l); break;
            case 5: hipLaunchKernelGGL(mega_one<5>, dim3(grid), dim3(512), LDS_BYTES, stream, p, l); break;
            default: hipLaunchKernelGGL(mega_one<6>, dim3(grid), dim3(512), LDS_BYTES, stream, p, l); break;
        } }
#else
    p.ph_lo = 0; p.ph_hi = NPH; p.coop = 1;
    if (hipMemsetAsync((char*)d_ws + OFF_BAR, 0, BAR_BYTES, stream) != hipSuccess) { fprintf(stderr, "kernel_launch: hipMemsetAsync of the barrier words failed\n"); return; }
    void* args[] = {&p};
    hipError_t e = hipLaunchCooperativeKernel((const void*)mega_all, dim3(grid), dim3(512), args, LDS_BYTES, stream);
    if (e != hipSuccess) fprintf(stderr, "cooperative launch failed: %s (grid %d)\n", hipGetErrorString(e), grid);
#endif
}
```
